# Optimizing an MI355X kernel written in HIP

```python
import jax, jax.numpy as jnp
from jax import lax
import numpy as np

D_MODEL = 2048
BATCH = 2
SEQ = 8192
DEPTH = 2

GRID_W = 64
CTX_LEN = 256
ROPE_THETA = 10000.0
Q_BLOCK = 128
LN_EPS = 1e-6
RMS_EPS = 1e-6

A_HEADS = 8
A_Q_LORA = 768
A_KV_LORA = 512
A_NOPE = 128
A_ROPE = 64
A_V = 128
A_SCALE = (A_NOPE + A_ROPE) ** -0.5
B_HEADS = 8
B_KV_HEADS = 2
B_GROUP = B_HEADS // B_KV_HEADS
B_HEAD_DIM = 128
B_SCALE = B_HEAD_DIM ** -0.5
A_WIDTH = A_HEADS * A_V
B_WIDTH = B_HEADS * B_HEAD_DIM
ATTN_WIDTH = A_WIDTH + B_WIDTH
ATTN_IN = A_Q_LORA + A_KV_LORA + A_ROPE + B_WIDTH + 2 * B_KV_HEADS * B_HEAD_DIM + ATTN_WIDTH
C_EXPAND = 2
C_WIDTH = C_EXPAND * D_MODEL
C_GROUPS = 16
C_GROUP_DIM = C_WIDTH // C_GROUPS

N_EVEN = (DEPTH + 1) // 2
N_ODD = DEPTH // 2
DEEPNORM_ALPHA = (2.0 * DEPTH) ** 0.25
DEEPNORM_BETA = (8.0 * DEPTH) ** -0.25

kernel_name = "hybrid_mla_gqa_fnet_deepnorm_dit"


def layer_norm(x):
    xf = x.astype(jnp.float32)
    mu = jnp.mean(xf, axis=-1, keepdims=True)
    var = jnp.mean(jnp.square(xf - mu), axis=-1, keepdims=True)
    return ((xf - mu) * lax.rsqrt(var + LN_EPS)).astype(x.dtype)


def rms_norm(x, g):
    xf = x.astype(jnp.float32)
    y = xf * lax.rsqrt(jnp.mean(xf * xf, axis=-1, keepdims=True) + RMS_EPS)
    return (y * g.astype(jnp.float32)).astype(x.dtype)


def axial_rope_angles(rows, rot_dim):
    r, col = jnp.meshgrid(jnp.arange(rows), jnp.arange(GRID_W), indexing="ij")
    r = r.reshape(-1).astype(jnp.float32)
    col = col.reshape(-1).astype(jnp.float32)
    n_freq = rot_dim // 4
    inv = ROPE_THETA ** (-jnp.arange(n_freq, dtype=jnp.float32) / n_freq)
    return jnp.concatenate([r[:, None] * inv, col[:, None] * inv], axis=-1)


def apply_rope(x, ang):
    cos = jnp.cos(ang)[None, :, None, :]
    sin = jnp.sin(ang)[None, :, None, :]
    xf = x.astype(jnp.float32).reshape(*x.shape[:-1], -1, 2)
    x1, x2 = xf[..., 0], xf[..., 1]
    out = jnp.stack([x1 * cos - x2 * sin, x1 * sin + x2 * cos], axis=-1)
    return out.reshape(x.shape).astype(x.dtype)


def block_attention(q, k, v, scale):
    b, s, g, r, dk = q.shape
    nblk = s // Q_BLOCK
    qb = jnp.moveaxis(q.reshape(b, nblk, Q_BLOCK, g, r, dk), 1, 0)

    def one_block(qi):
        sc = jnp.einsum("bqgrd,bkgd->bgrqk", qi, k, preferred_element_type=jnp.float32) * scale
        p = jax.nn.softmax(sc, axis=-1).astype(v.dtype)
        return jnp.einsum("bgrqk,bkge->bqgre", p, v)

    out = lax.map(one_block, qb)
    return jnp.moveaxis(out, 0, 1).reshape(b, s, g, r, v.shape[-1])


def attn_project(h, w_in, wq_b, q_lora_g, kv_lora_g, wkv_b, qn_g, kn_g):
    b, l, _ = h.shape
    splits = np.cumsum([A_Q_LORA, A_KV_LORA, A_ROPE, B_WIDTH,
                        B_KV_HEADS * B_HEAD_DIM, B_KV_HEADS * B_HEAD_DIM]).tolist()
    z = h @ w_in
    c_q, c_kv, k_pe, q_b, k_b, v_b, gate = jnp.split(z, splits, axis=-1)
    q_a = (rms_norm(c_q, q_lora_g) @ wq_b).reshape(b, l, A_HEADS, A_NOPE + A_ROPE)
    kv_a = (rms_norm(c_kv, kv_lora_g) @ wkv_b).reshape(b, l, A_HEADS, A_NOPE + A_V)
    q_nope, q_pe = q_a[..., :A_NOPE], q_a[..., A_NOPE:]
    k_nope, v_a = kv_a[..., :A_NOPE], kv_a[..., A_NOPE:]
    k_pe = k_pe.reshape(b, l, 1, A_ROPE)
    q_b = rms_norm(q_b.reshape(b, l, B_HEADS, B_HEAD_DIM), qn_g)
    k_b = rms_norm(k_b.reshape(b, l, B_KV_HEADS, B_HEAD_DIM), kn_g)
    v_b = v_b.reshape(b, l, B_KV_HEADS, B_HEAD_DIM)
    return q_nope, q_pe, k_nope, k_pe, v_a, q_b, k_b, v_b, gate


def mla_qk(q_nope, q_pe, k_nope, k_pe):
    b, l, h, _ = q_nope.shape
    q = jnp.concatenate([q_nope, q_pe], axis=-1)[:, :, :, None, :]
    k = jnp.concatenate([k_nope, jnp.broadcast_to(k_pe, (b, l, h, A_ROPE))], axis=-1)
    return q, k


def gated_out(y_a, y_b, gate, w_out):
    b, l = y_a.shape[:2]
    y = jnp.concatenate([y_a.reshape(b, l, A_WIDTH), y_b.reshape(b, l, B_WIDTH)], axis=-1)
    return (y * jax.nn.silu(gate)) @ w_out


def attention_mixer(h_lat, h_ctx, ang_a, ang_b, w_in, wq_b, q_lora_g, kv_lora_g, wkv_b,
                    qn_g, kn_g, w_out, with_ctx_queries):
    b, s, _ = h_lat.shape
    lqn, lqp, lkn, lkp, lva, lqb, lkb, lvb, lgate = attn_project(
        h_lat, w_in, wq_b, q_lora_g, kv_lora_g, wkv_b, qn_g, kn_g)
    cqn, cqp, ckn, ckp, cva, cqb, ckb, cvb, cgate = attn_project(
        h_ctx, w_in, wq_b, q_lora_g, kv_lora_g, wkv_b, qn_g, kn_g)
    lqp, lkp = apply_rope(lqp, ang_a), apply_rope(lkp, ang_a)
    lqb, lkb = apply_rope(lqb, ang_b), apply_rope(lkb, ang_b)
    lq_a, lk_a = mla_qk(lqn, lqp, lkn, lkp)
    cq_a, ck_a = mla_qk(cqn, cqp, ckn, ckp)
    k_a_all = jnp.concatenate([ck_a, lk_a], axis=1)
    v_a_all = jnp.concatenate([cva, lva], axis=1)
    k_b_all = jnp.concatenate([ckb, lkb], axis=1)
    v_b_all = jnp.concatenate([cvb, lvb], axis=1)
    y_a = block_attention(lq_a, k_a_all, v_a_all, A_SCALE)
    y_b = block_attention(lqb.reshape(b, s, B_KV_HEADS, B_GROUP, B_HEAD_DIM), k_b_all, v_b_all, B_SCALE)
    out_lat = gated_out(y_a, y_b, lgate, w_out)
    out_ctx = None
    if with_ctx_queries:
        lc = h_ctx.shape[1]
        yc_a = block_attention(cq_a, ck_a, cva, A_SCALE)
        yc_b = block_attention(cqb.reshape(b, lc, B_KV_HEADS, B_GROUP, B_HEAD_DIM), ckb, cvb, B_SCALE)
        out_ctx = gated_out(yc_a, yc_b, cgate, w_out)
    return out_lat, out_ctx


def fourier_mixer(h, w_in, w_out):
    b, l, _ = h.shape
    u, gate = jnp.split(h @ w_in, 2, axis=-1)
    ug = u.reshape(b, l, C_GROUPS, C_GROUP_DIM).astype(jnp.float32)
    f = jnp.fft.fft2(ug, axes=(1, 3), norm="ortho").real.astype(h.dtype)
    y = f.reshape(b, l, C_WIDTH) * jax.nn.silu(gate)
    return y @ w_out


def modulation(cvec, ada_w, ada_b):
    m = jax.nn.silu(cvec) @ ada_w + ada_b
    return jnp.split(m, 3, axis=-1)


def modulate(x, shift, scale):
    return layer_norm(x) * (1.0 + scale) + shift


def post_norm(x, out, gate, g, bias):
    return layer_norm(DEEPNORM_ALPHA * x + gate * out) * g + bias


def setup_inputs(seed: int = 0) -> dict:
    key = jax.random.key(seed)
    ks = jax.random.split(key, 24)

    def nrm(k, shape, s):
        return jax.random.normal(k, shape, jnp.float32) * s

    def gain(k, shape):
        return 1.0 + 0.02 * jax.random.normal(k, shape, jnp.float32)

    return {
        "x": nrm(ks[0], (BATCH, SEQ, D_MODEL), 1.0),
        "c": nrm(ks[1], (BATCH, D_MODEL), 1.0),
        "ctx": nrm(ks[2], (BATCH, CTX_LEN, D_MODEL), 1.0),
        "c_ctx": nrm(ks[3], (D_MODEL,), 1.0),
        "ada_w": nrm(ks[4], (DEPTH, D_MODEL, 3 * D_MODEL), 0.5 * D_MODEL ** -0.5),
        "ada_b": nrm(ks[5], (DEPTH, 3 * D_MODEL), 0.01),
        "ln_g": gain(ks[6], (DEPTH, D_MODEL)),
        "ln_b": nrm(ks[7], (DEPTH, D_MODEL), 0.01),
        "w_in_attn": nrm(ks[8], (N_EVEN, D_MODEL, ATTN_IN), D_MODEL ** -0.5),
        "wq_b": nrm(ks[9], (N_EVEN, A_Q_LORA, A_HEADS * (A_NOPE + A_ROPE)), A_Q_LORA ** -0.5),
        "q_lora_norm": gain(ks[10], (N_EVEN, A_Q_LORA)),
        "kv_lora_norm": gain(ks[11], (N_EVEN, A_KV_LORA)),
        "wkv_b": nrm(ks[12], (N_EVEN, A_KV_LORA, A_HEADS * (A_NOPE + A_V)), A_KV_LORA ** -0.5),
        "q_norm_b": gain(ks[13], (N_EVEN, B_HEAD_DIM)),
        "k_norm_b": gain(ks[14], (N_EVEN, B_HEAD_DIM)),
        "w_out_attn": nrm(ks[15], (N_EVEN, ATTN_WIDTH, D_MODEL), DEEPNORM_BETA * ATTN_WIDTH ** -0.5),
        "w_in_fourier": nrm(ks[16], (N_ODD, D_MODEL, 2 * C_WIDTH), D_MODEL ** -0.5),
        "w_out_fourier": nrm(ks[17], (N_ODD, C_WIDTH, D_MODEL), DEEPNORM_BETA * C_WIDTH ** -0.5),
    }


def reference(x, c, ctx, c_ctx, ada_w, ada_b, ln_g, ln_b, w_in_attn, wq_b, q_lora_norm,
              kv_lora_norm, wkv_b, q_norm_b, k_norm_b, w_out_attn, w_in_fourier, w_out_fourier):
    rows = x.shape[1] // GRID_W
    ang_a = axial_rope_angles(rows, A_ROPE)
    ang_b = axial_rope_angles(rows, B_HEAD_DIM)
    xc = ctx
    for i in range(DEPTH):
        j = i // 2
        ctx_needed = i < DEPTH - 1
        sh_l, sc_l, g_l = [m[:, None, :] for m in modulation(c, ada_w[i], ada_b[i])]
        h_lat = modulate(x, sh_l, sc_l)
        o_ctx = None
        g_c = None
        if i % 2 == 0:
            sh_c, sc_c, g_c = modulation(c_ctx, ada_w[i], ada_b[i])
            h_ctx = modulate(xc, sh_c, sc_c)
            o_lat, o_ctx = attention_mixer(
                h_lat, h_ctx, ang_a, ang_b, w_in_attn[j], wq_b[j], q_lora_norm[j],
                kv_lora_norm[j], wkv_b[j], q_norm_b[j], k_norm_b[j], w_out_attn[j], ctx_needed)
        else:
            o_lat = fourier_mixer(h_lat, w_in_fourier[j], w_out_fourier[j])
            if ctx_needed:
                sh_c, sc_c, g_c = modulation(c_ctx, ada_w[i], ada_b[i])
                o_ctx = fourier_mixer(modulate(xc, sh_c, sc_c), w_in_fourier[j], w_out_fourier[j])
        x = post_norm(x, o_lat, g_l, ln_g[i], ln_b[i])
        if ctx_needed:
            xc = post_norm(xc, o_ctx, g_c, ln_g[i], ln_b[i])
    return x
```

```cpp
#include <hip/hip_runtime.h>
#include <hip/hip_cooperative_groups.h>
#include <cstdio>
#include <cstdint>
namespace cg = cooperative_groups;

#ifndef MK_MULTI
#define MK_MULTI 0
#endif
#ifndef PHMASK
#define PHMASK 0xffff
#endif
#define PH_ON(n) ((PHMASK >> (n)) & 1)

typedef unsigned short bf16_t;
typedef short bf16x8 __attribute__((ext_vector_type(8)));
typedef short s16x4 __attribute__((ext_vector_type(4)));
typedef float f32x4 __attribute__((ext_vector_type(4)));
typedef float f32x16 __attribute__((ext_vector_type(16)));
typedef unsigned u32x4 __attribute__((ext_vector_type(4)));
typedef unsigned u32x2 __attribute__((ext_vector_type(2)));
#define LAS __attribute__((address_space(3)))

constexpr int DM = 2048, NB = 2, SEQ = 8192, CTX = 256, NLAT = NB * SEQ, NTOK = NLAT + NB * CTX, LKV = SEQ + CTX;
constexpr int ZW = 3072;
constexpr int NWI = 5120;
constexpr float ALPHA = 1.4142135623730951f;
constexpr int NPH = 14;
constexpr int LDS_BYTES = 131072;

constexpr size_t al256(size_t x) { return (x + 255) / 256 * 256; }
constexpr size_t OFF_WI = 0;
constexpr size_t OFF_WQ = OFF_WI + (size_t)NWI * 2048 * 2;
constexpr size_t OFF_WKV = OFF_WQ + (size_t)1536 * 768 * 2;
constexpr size_t OFF_WO = OFF_WKV + (size_t)2048 * 512 * 2;
constexpr size_t OFF_WFU = OFF_WO + (size_t)2048 * 2048 * 2;
constexpr size_t OFF_WFG = OFF_WFU + (size_t)4096 * 2048 * 2;
constexpr size_t OFF_WOF = OFF_WFG + (size_t)4096 * 2048 * 2;
constexpr size_t OFF_WUB = OFF_WOF + (size_t)2048 * 4096 * 2;
constexpr size_t OFF_TT = OFF_WUB + (size_t)2048 * 4096 * 2;
constexpr size_t OFF_TRIG = OFF_TT + (size_t)256 * 256 * 2;
constexpr size_t OFF_MOD = OFF_TRIG + (size_t)1024 * 2048 * 2;
constexpr size_t OFF_L = al256(OFF_MOD + (size_t)2 * 3 * 6144 * 4);
constexpr size_t OFF_H = OFF_L;
constexpr size_t OFF_CQN = OFF_H;
constexpr size_t OFF_CKVN = OFF_CQN + (size_t)NLAT * 768 * 2;
constexpr size_t OFF_Z = OFF_H + (size_t)NTOK * 2048 * 2;
constexpr size_t OFF_SG0 = OFF_Z + (size_t)NTOK * ZW * 2;
constexpr size_t OFF_QB = OFF_SG0 + (size_t)NLAT * 2048 * 2;
constexpr size_t OFF_KB = OFF_QB + (size_t)NLAT * 1024 * 2;
constexpr size_t OFF_VB = OFF_KB + (size_t)NB * 2 * LKV * 128 * 2;
constexpr size_t OFF_KPE = OFF_VB + (size_t)NB * 2 * LKV * 128 * 2;
constexpr size_t OFF_QA = OFF_KPE + (size_t)NB * LKV * 64 * 2;
constexpr size_t OFF_KA = OFF_QA + (size_t)NLAT * 1536 * 2;
constexpr size_t OFF_VA = OFF_KA + (size_t)NB * 8 * LKV * 128 * 2;
constexpr size_t END0 = OFF_VA + (size_t)NB * 8 * LKV * 128 * 2;
constexpr int NZS = 33024;
constexpr size_t OFF_ZS = OFF_L;
constexpr size_t OFF_H1 = OFF_ZS;
constexpr size_t OFF_PT = OFF_ZS + (size_t)NZS * 2048 * 2;
constexpr size_t OFF_XR = OFF_PT;
constexpr size_t OFF_XR128 = OFF_XR + (size_t)NLAT * 2048 * 2;
constexpr size_t OFF_SG = OFF_PT + (size_t)4096 * NLAT * 2;
constexpr size_t END1 = OFF_SG + (size_t)NLAT * 4096 * 2;
constexpr size_t WS_NEED = END0 > END1 ? END0 : END1;

struct Params {
    const float *x, *c, *ctx, *c_ctx, *ada_w, *ada_b, *ln_g, *ln_b, *w_in_attn, *wq_b, *q_lora_g, *kv_lora_g, *wkv_b, *qn_g, *kn_g, *w_out_attn, *w_in_f, *w_out_f;
    float* out; unsigned char* ws; int ph_lo, ph_hi;
};

__device__ __forceinline__ unsigned cvtpk(float lo, float hi) { unsigned r; asm("v_cvt_pk_bf16_f32 %0, %1, %2" : "=v"(r) : "v"(lo), "v"(hi)); return r; }
__device__ __forceinline__ int tid_l() { int t = threadIdx.x; asm volatile("" : "+v"(t)); return t; }
__device__ __forceinline__ int bid_l() { int t = blockIdx.x; asm volatile("" : "+s"(t)); return t; }
__device__ __forceinline__ float bflo(unsigned w) { return __uint_as_float(w << 16); }
__device__ __forceinline__ float bfhi(unsigned w) { return __uint_as_float(w & 0xffff0000u); }
__device__ __forceinline__ float bf2f(bf16_t b) { return __uint_as_float(((unsigned)b) << 16); }
__device__ __forceinline__ bf16_t f2bf(float f) { return (bf16_t)(cvtpk(f, 0.f) & 0xffffu); }
__device__ __forceinline__ float wave_sum(float v) {
#pragma unroll
    for (int o = 32; o > 0; o >>= 1) v += __shfl_xor(v, o);
    return v;
}
__device__ __forceinline__ float sum16(float v) {
#pragma unroll
    for (int o = 8; o > 0; o >>= 1) v += __shfl_xor(v, o);
    return v;
}
__device__ __forceinline__ float silu(float x) { return x / (1.f + __expf(-x)); }
__device__ __forceinline__ void unpack8(u32x4 w, float (&v)[8]) {
    v[0] = bflo(w.x); v[1] = bfhi(w.x); v[2] = bflo(w.y); v[3] = bfhi(w.y); v[4] = bflo(w.z); v[5] = bfhi(w.z); v[6] = bflo(w.w); v[7] = bfhi(w.w);
}
__device__ __forceinline__ u32x4 pack8(const float (&v)[8]) { u32x4 w; w.x = cvtpk(v[0], v[1]); w.y = cvtpk(v[2], v[3]); w.z = cvtpk(v[4], v[5]); w.w = cvtpk(v[6], v[7]); return w; }
__device__ __forceinline__ float cos_rev(float r) { return __builtin_amdgcn_cosf(r); }
__device__ __forceinline__ float sin_rev(float r) { return __builtin_amdgcn_sinf(r); }
__device__ __forceinline__ void rope8(float (&v)[8], int i0, int nhalf, float prow, float pcol) {
#pragma unroll
    for (int j = 0; j < 4; ++j) {
        const int i = i0 + j; const int fi = i < nhalf ? i : i - nhalf; const float pos = i < nhalf ? prow : pcol;
        const float inv = __builtin_amdgcn_exp2f(-(float)fi * (13.287712379549449f / (float)nhalf));
        const float rev = pos * inv * 0.15915494309189535f;
        const float cs = cos_rev(rev), sn = sin_rev(rev), a = v[2 * j], b = v[2 * j + 1];
        v[2 * j] = a * cs - b * sn; v[2 * j + 1] = a * sn + b * cs;
    }
}

namespace pg8 {
constexpr int BM = 256, BK = 64, HALF = 128, HTB = HALF * BK * 2, NXCD = 8, WGM = 8;
__device__ __forceinline__ int lds_byte(int r, int c) { const int st = (r >> 4) * 2 + (c >> 5), rr = r & 15, cc = c & 31, ob = rr * 64 + cc * 2; return st * 1024 + (ob ^ (((ob >> 9) & 1) << 5)); }
__device__ __forceinline__ void stage_rc(int b, int& R, int& C) { const int st = b / 1024, sb = b % 1024, swz = sb ^ (((sb >> 9) & 1) << 5); R = (st >> 1) * 16 + swz / 64; C = (st & 1) * 32 + (swz % 64) / 2; }
__device__ __forceinline__ int perm32(int rho) { const int n = rho >> 4, i = rho & 15; return 8 * (i >> 2) + 4 * n + (i & 3); }
struct Unit { int pm, pn; };
struct Gemm { const bf16_t* A; const bf16_t* Bt; int M, N, K, lda, ldb; };
struct StaticOrder {
    int nM, nN, nwg, G, c;
    __device__ void init(int M, int N, int G_, int c_) { nM = M / BM; nN = N / BM; nwg = nM * nN; G = G_; c = c_; }
    __device__ bool next(int i, Unit& u) const {
        const long L = (long)i * G + c; if (L >= nwg) return false;
        int wgid = (int)L; { const int q = nwg / NXCD, r = nwg % NXCD, xcd = wgid % NXCD, off = wgid / NXCD; wgid = (xcd < r ? xcd * (q + 1) : r * (q + 1) + (xcd - r) * q) + off; }
        const int nig = WGM * nN, gid = wgid / nig, fm = gid * WGM, gsz = (nM - fm) < WGM ? (nM - fm) : WGM;
        u.pm = fm + ((wgid % nig) % gsz); u.pn = (wgid % nig) / gsz; return true;
    }
};
struct OneUnit { int pm, pn; __device__ bool next(int i, Unit& u) const { if (i) return false; u.pm = pm; u.pn = pn; return true; } };

template <class Epi, class Sched>
__device__ __forceinline__ void gemm_phase(LAS unsigned char* lds, const Gemm g, const Sched& S, const Epi& E) {
    const int tid = tid_l(), wid = __builtin_amdgcn_readfirstlane(tid >> 6), lane = tid & 63, wr = wid >> 2, wc = wid & 3, fr = lane & 15, fq = lane >> 4;
    const int K = g.K, nt = K / BK;
    unsigned voffA[2], voffB[2];
#pragma unroll
    for (int i = 0; i < 2; ++i) { int R, C; stage_rc(tid * 16 + i * 8192, R, C); const int Rb = Epi::PERM ? ((R & ~31) + perm32(R & 31)) : R;
        voffA[i] = (unsigned)(R * g.lda + C) * 2u; voffB[i] = (unsigned)(Rb * g.ldb + C) * 2u; }
    const size_t kstep = (size_t)(BK * 2);
    const size_t hsA = (size_t)HALF * g.lda * 2, hsB = (size_t)HALF * g.ldb * 2;
    const size_t tsA = 2 * hsA, tsB = 2 * hsB;
    const unsigned ldsw = (unsigned)wid * 1024u;
    const int aoff = lds_byte(wr * 64 + fr, fq * 8), boff = lds_byte(wc * 32 + fr, fq * 8);
#define PG8_SA(b, h) (((b) * 2 + (h)) * HTB)
#define PG8_SB(b, h) ((4 + (b) * 2 + (h)) * HTB)
#define PG8_STAGE(bufoff, gbase, voff) do { _Pragma("unroll") for (int _i = 0; _i < 2; ++_i) \
        __builtin_amdgcn_global_load_lds((const unsigned*)((const char*)(gbase) + (voff)[_i]), (LAS unsigned*)(lds + (bufoff) + ldsw + _i * 8192), 16, 0, 0); } while (0)
#define PG8_LDA(dst, b, h) do { _Pragma("unroll") for (int m = 0; m < 4; ++m) _Pragma("unroll") for (int k = 0; k < 2; ++k) dst[m][k] = *(const LAS bf16x8*)(lds + PG8_SA(b, h) + aoff + m * 2048 + k * 1024); } while (0)
#define PG8_LDB(dst, b, h) do { _Pragma("unroll") for (int n = 0; n < 2; ++n) _Pragma("unroll") for (int k = 0; k < 2; ++k) dst[n][k] = *(const LAS bf16x8*)(lds + PG8_SB(b, h) + boff + n * 2048 + k * 1024); } while (0)
#define PG8_MMA(ai, bj, At, Bt) do { __builtin_amdgcn_s_setprio(1); _Pragma("unroll") for (int m = 0; m < 4; ++m) _Pragma("unroll") for (int n = 0; n < 2; ++n) _Pragma("unroll") for (int k = 0; k < 2; ++k) \
        acc[ai][bj][m][n] = __builtin_amdgcn_mfma_f32_16x16x32_bf16(Bt[n][k], At[m][k], acc[ai][bj][m][n], 0, 0, 0); __builtin_amdgcn_s_setprio(0); } while (0)
#define PG8_WAIT_V(n) asm volatile("s_waitcnt vmcnt(" #n ")" ::: "memory")
#define PG8_WAIT_L(n) asm volatile("s_waitcnt lgkmcnt(" #n ")" ::: "memory")
#define PG8_BAR __builtin_amdgcn_s_barrier()
#define PG8_SCHED __builtin_amdgcn_sched_barrier(0)
    Unit cur, nxt; int ui = 0;
    if (!S.next(0, cur)) return;
    f32x4 acc[2][2][4][2];
#pragma unroll
    for (int a = 0; a < 2; ++a)
#pragma unroll
        for (int b = 0; b < 2; ++b)
#pragma unroll
            for (int m = 0; m < 4; ++m)
#pragma unroll
                for (int n = 0; n < 2; ++n) acc[a][b][m][n] = (f32x4){0.f, 0.f, 0.f, 0.f};
    bf16x8 At[4][2], B0[2][2], B1[2][2];
    const char* cA = (const char*)g.A + (size_t)cur.pm * tsA; const char* cB = (const char*)g.Bt + (size_t)cur.pn * tsB;
    PG8_STAGE(PG8_SB(0, 0), cB, voffB); PG8_STAGE(PG8_SA(0, 0), cA, voffA); PG8_STAGE(PG8_SB(0, 1), cB + hsB, voffB); PG8_STAGE(PG8_SA(0, 1), cA + hsA, voffA);
    if (wr == 1) PG8_BAR;
    PG8_WAIT_V(4); PG8_BAR;
    PG8_STAGE(PG8_SB(1, 0), cB + kstep, voffB); PG8_STAGE(PG8_SA(1, 0), cA + kstep, voffA); PG8_STAGE(PG8_SB(1, 1), cB + hsB + kstep, voffB);
    PG8_WAIT_V(6); PG8_BAR;
    for (;;) {
        const bool has_next = S.next(ui + 1, nxt);
        const char* nA = has_next ? (const char*)g.A + (size_t)nxt.pm * tsA : cA; const char* nB = has_next ? (const char*)g.Bt + (size_t)nxt.pn * tsB : cB;
        for (int t = 0; t < nt; t += 2) {
            const bool last = (t == nt - 2);
            const char* a1 = cA + (size_t)(t + 1) * kstep;
            const char* a2 = last ? nA : cA + (size_t)(t + 2) * kstep; const char* b2 = last ? nB : cB + (size_t)(t + 2) * kstep;
            const char* a3 = a2 + kstep; const char* b3 = b2 + kstep;
            PG8_LDB(B0, 0, 0); PG8_SCHED; PG8_LDA(At, 0, 0); PG8_STAGE(PG8_SA(1, 1), a1 + hsA, voffA);
            PG8_WAIT_L(8); PG8_BAR; PG8_WAIT_L(0); PG8_MMA(0, 0, At, B0); PG8_BAR; PG8_SCHED;
            PG8_LDB(B1, 0, 1); PG8_STAGE(PG8_SB(0, 0), b2, voffB);
            PG8_BAR; PG8_WAIT_L(0); PG8_MMA(0, 1, At, B1); PG8_BAR;
            PG8_LDA(At, 0, 1); PG8_STAGE(PG8_SA(0, 0), a2, voffA);
            PG8_BAR; PG8_WAIT_L(0); PG8_MMA(1, 0, At, B0); PG8_BAR; PG8_SCHED;
            PG8_STAGE(PG8_SB(0, 1), b2 + hsB, voffB);
            PG8_WAIT_V(6); PG8_BAR; PG8_MMA(1, 1, At, B1); PG8_BAR;
            PG8_LDB(B0, 1, 0); PG8_SCHED; PG8_LDA(At, 1, 0); PG8_STAGE(PG8_SA(0, 1), a2 + hsA, voffA);
            PG8_WAIT_L(8); PG8_BAR; PG8_WAIT_L(0); PG8_MMA(0, 0, At, B0); PG8_BAR; PG8_SCHED;
            PG8_LDB(B1, 1, 1); PG8_STAGE(PG8_SB(1, 0), b3, voffB);
            PG8_BAR; PG8_WAIT_L(0); PG8_MMA(0, 1, At, B1); PG8_BAR;
            PG8_LDA(At, 1, 1); PG8_STAGE(PG8_SA(1, 0), a3, voffA);
            PG8_BAR; PG8_WAIT_L(0); PG8_MMA(1, 0, At, B0); PG8_BAR; PG8_SCHED;
            PG8_STAGE(PG8_SB(1, 1), b3 + hsB, voffB);
            PG8_WAIT_V(6); PG8_BAR; PG8_MMA(1, 1, At, B1); PG8_BAR;
        }
        E(acc, cur, wr, wc, fr, fq);
        if (!has_next) break;
#pragma unroll
        for (int a = 0; a < 2; ++a)
#pragma unroll
            for (int b = 0; b < 2; ++b)
#pragma unroll
                for (int m = 0; m < 4; ++m)
#pragma unroll
                    for (int n = 0; n < 2; ++n) acc[a][b][m][n] = (f32x4){0.f, 0.f, 0.f, 0.f};
        cur = nxt; cA = nA; cB = nB; ++ui;
    }
    PG8_WAIT_V(0);
    if (wr == 0) PG8_BAR;
    PG8_BAR;
#undef PG8_SA
#undef PG8_SB
#undef PG8_STAGE
#undef PG8_LDA
#undef PG8_LDB
#undef PG8_MMA
#undef PG8_WAIT_V
#undef PG8_WAIT_L
#undef PG8_BAR
#undef PG8_SCHED
}
template <class F> struct EpiB { static constexpr bool PERM = true; F f;
    __device__ __forceinline__ void operator()(const f32x4 (&acc)[2][2][4][2], const Unit& u, int wr, int wc, int fr, int fq) const {
#pragma unroll
        for (int ai = 0; ai < 2; ++ai)
#pragma unroll
            for (int m = 0; m < 4; ++m)
#pragma unroll
                for (int bj = 0; bj < 2; ++bj) {
                    const int row = u.pm * BM + ai * HALF + wr * 64 + m * 16 + fr, col = u.pn * BM + bj * HALF + wc * 32 + 8 * fq;
                    float v[8] = {acc[ai][bj][m][0][0], acc[ai][bj][m][0][1], acc[ai][bj][m][0][2], acc[ai][bj][m][0][3], acc[ai][bj][m][1][0], acc[ai][bj][m][1][1], acc[ai][bj][m][1][2], acc[ai][bj][m][1][3]};
                    f(row, col, v); }
    } };
template <class F> struct EpiF { static constexpr bool PERM = false; F f;
    __device__ __forceinline__ void operator()(const f32x4 (&acc)[2][2][4][2], const Unit& u, int wr, int wc, int fr, int fq) const {
#pragma unroll
        for (int ai = 0; ai < 2; ++ai)
#pragma unroll
            for (int m = 0; m < 4; ++m)
#pragma unroll
                for (int bj = 0; bj < 2; ++bj)
#pragma unroll
                    for (int n = 0; n < 2; ++n) {
                        const int row = u.pm * BM + ai * HALF + wr * 64 + m * 16 + fr, col = u.pn * BM + bj * HALF + wc * 32 + 16 * n + 4 * fq;
                        f(row, col, acc[ai][bj][m][n]); }
    } };
}

struct FStore { bf16_t* O; int ldc;
    __device__ __forceinline__ void operator()(int row, int col, float (&v)[8]) const { *(u32x4*)(O + (size_t)row * ldc + col) = pack8(v); } };
struct FSilu { bf16_t* O; int ldc;
    __device__ __forceinline__ void operator()(int row, int col, float (&v)[8]) const {
#pragma unroll
        for (int j = 0; j < 8; ++j) v[j] = silu(v[j]);
        *(u32x4*)(O + (size_t)row * ldc + col) = pack8(v); } };
struct FZ { bf16_t* Z; bf16_t* SG0;
    __device__ __forceinline__ void operator()(int row, int col, float (&v)[8]) const {
        if (col < ZW) { *(u32x4*)(Z + (size_t)row * ZW + col) = pack8(v); }
        else if (row < NLAT) {
#pragma unroll
            for (int j = 0; j < 8; ++j) v[j] = silu(v[j]);
            *(u32x4*)(SG0 + (size_t)row * 2048 + (col - ZW)) = pack8(v); } } };
struct FQa { bf16_t* Qa;
    __device__ __forceinline__ void operator()(int row, int col, float (&v)[8]) const {
        const int d = col % 192;
        if (d >= 128) { const int s = row & (SEQ - 1); rope8(v, (d - 128) >> 1, 16, (float)(s >> 6), (float)(s & 63)); }
        *(u32x4*)(Qa + (size_t)row * 1536 + col) = pack8(v); } };
struct FKva { bf16_t* Ka; bf16_t* Va;
    __device__ __forceinline__ void operator()(int row, int col, float (&v)[8]) const {
        const int head = col >> 8, dd = col & 255, d = dd & 127; int b, pos;
        if (row < NLAT) { b = row >> 13; pos = CTX + (row & (SEQ - 1)); } else { const int cr = row - NLAT; b = cr >> 8; pos = cr & 255; }
        bf16_t* dst = (dd >= 128 ? Va : Ka) + ((size_t)((b * 8 + head) * LKV + pos) * 128 + d);
        *(u32x4*)dst = pack8(v); } };
struct FRes { const float* xin; const float* gate; float* out;
    __device__ __forceinline__ void operator()(int row, int col, const f32x4& a) const {
        const int b = row >> 13; const size_t idx = (size_t)row * DM + col;
        const f32x4 xv = *(const f32x4*)(xin + idx), gv = *(const f32x4*)(gate + b * 6144 + col);
        *(f32x4*)(out + idx) = xv * ALPHA + gv * a; } };
struct FXr { bf16_t* XR; bf16_t* XR128;
    __device__ __forceinline__ void operator()(int row, int col, float (&v)[8]) const {
        if (col < 32768) { const int k2 = col & 127, s = (col >> 7) & 7, bg = col >> 10, b = bg >> 4, g = bg & 15;
            *(u32x4*)(XR + (size_t)(b * SEQ + 8 * row + s) * 2048 + g * 128 + k2) = pack8(v); }
        else { const int bg = (col - 32768) >> 3, b = bg >> 4, g = bg & 15;
#pragma unroll
            for (int s = 0; s < 8; ++s) XR128[(size_t)(b * SEQ + 8 * row + s) * 16 + g] = f2bf(v[s]); } } };

#define KSWZ(row, colB) ((row) * 256 + ((colB) ^ (((row) & 7) << 4)))
#define XSWZ(row, colB) ((row) * 128 + ((colB) ^ (((row) & 7) << 4)))
#define SBAR() __builtin_amdgcn_sched_barrier(0)
constexpr int A_SHM_V = 64 * 128 * 2, A_SHM_K = 64 * 128 * 2, A_SHM_X = 64 * 64 * 2;
__device__ __forceinline__ unsigned cvtpk_v(float lo, float hi) { unsigned r; asm volatile("v_cvt_pk_bf16_f32 %0, %1, %2" : "=v"(r) : "v"(lo), "v"(hi)); return r; }
__device__ __forceinline__ int crow(int r, int hi) { return (r & 3) + 8 * (r >> 2) + 4 * hi; }
__device__ __forceinline__ void partialSM(f32x16& p0, f32x16& p1, float& m_reg, float& mn, float& alpha, const float SCALE) {
    const float C = SCALE * 1.4426950408889634f; const float THRS = 8.f / SCALE;
    float pmax = p0[0];
#pragma unroll
    for (int r = 1; r < 16; ++r) pmax = fmaxf(pmax, p0[r]);
#pragma unroll
    for (int r = 0; r < 16; ++r) pmax = fmaxf(pmax, p1[r]);
    { auto rr = __builtin_amdgcn_permlane32_swap(__float_as_uint(pmax), __float_as_uint(pmax), false, false);
      pmax = fmaxf(__uint_as_float(rr[0]), __uint_as_float(rr[1])); }
    if (__builtin_expect(__all(pmax - m_reg <= THRS), 1)) { mn = m_reg; alpha = 1.f; }
    else { mn = fmaxf(m_reg, pmax); alpha = __builtin_amdgcn_exp2f((m_reg - mn) * C); m_reg = mn; }
    const float mnC = -mn * C;
#pragma unroll
    for (int r = 0; r < 16; ++r) p0[r] = fmaf(p0[r], C, mnC);
#pragma unroll
    for (int r = 0; r < 16; ++r) p1[r] = fmaf(p1[r], C, mnC);
#pragma unroll
    for (int r = 0; r < 16; ++r) p0[r] = __builtin_amdgcn_exp2f(p0[r]);
}
__device__ __forceinline__ void finishSM(f32x16& p0, f32x16& p1, float alpha, float& l_reg, bf16x8& pa0, bf16x8& pa1, bf16x8& pa2, bf16x8& pa3) {
#pragma unroll
    for (int r = 0; r < 16; ++r) p1[r] = __builtin_amdgcn_exp2f(p1[r]);
    float ps = 0;
#pragma unroll
    for (int r = 0; r < 16; ++r) ps += p0[r];
#pragma unroll
    for (int r = 0; r < 16; ++r) ps += p1[r];
    { auto rr = __builtin_amdgcn_permlane32_swap(__float_as_uint(ps), __float_as_uint(ps), false, false);
      ps = __uint_as_float(rr[0]) + __uint_as_float(rr[1]); }
    l_reg = l_reg * alpha + ps;
#define PK4(P, BASE, OUT) do { unsigned a0 = cvtpk_v(P[BASE + 0], P[BASE + 1]), a1 = cvtpk_v(P[BASE + 2], P[BASE + 3]);   \
    unsigned b0 = cvtpk_v(P[BASE + 4], P[BASE + 5]), b1 = cvtpk_v(P[BASE + 6], P[BASE + 7]);                              \
    auto r0 = __builtin_amdgcn_permlane32_swap(a0, b0, false, false); auto r1 = __builtin_amdgcn_permlane32_swap(a1, b1, false, false); \
    u32x4 w = {r0[0], r1[0], r0[1], r1[1]}; OUT = *reinterpret_cast<bf16x8*>(&w); } while (0)
    PK4(p0, 0, pa0); PK4(p0, 8, pa1); PK4(p1, 0, pa2); PK4(p1, 8, pa3);
#undef PK4
}
template <int XD>
__device__ __forceinline__ void qkt(f32x16& p0, f32x16& p1, const char* Ks, const char* Xs, const bf16x8* qr, const bf16x8* qx, int r32, int hi) {
    p0 = f32x16{}; p1 = f32x16{};
#pragma unroll
    for (int d0 = 0; d0 < 8; ++d0) { const int cb = (d0 * 16 + hi * 8) * 2;
        bf16x8 b0 = *reinterpret_cast<const bf16x8*>(Ks + KSWZ(r32, cb));
        bf16x8 b1 = *reinterpret_cast<const bf16x8*>(Ks + KSWZ(32 + r32, cb));
        p0 = __builtin_amdgcn_mfma_f32_32x32x16_bf16(b0, qr[d0], p0, 0, 0, 0);
        p1 = __builtin_amdgcn_mfma_f32_32x32x16_bf16(b1, qr[d0], p1, 0, 0, 0); }
    if constexpr (XD > 0) {
#pragma unroll
        for (int d0 = 0; d0 < XD / 16; ++d0) { const int cb = (d0 * 16 + hi * 8) * 2;
            bf16x8 b0 = *reinterpret_cast<const bf16x8*>(Xs + XSWZ(r32, cb));
            bf16x8 b1 = *reinterpret_cast<const bf16x8*>(Xs + XSWZ(32 + r32, cb));
            p0 = __builtin_amdgcn_mfma_f32_32x32x16_bf16(b0, qx[d0], p0, 0, 0, 0);
            p1 = __builtin_amdgcn_mfma_f32_32x32x16_bf16(b1, qx[d0], p1, 0, 0, 0); }
    }
}
__device__ __forceinline__ int v_st(int k, int c) { const int kk = (k & ~0xC) | ((k & 4) << 1) | ((k & 8) >> 1); return ((kk >> 3) * 4 + (c >> 5)) * 512 + ((kk & 7) * 32 + (c & 31)) * 2; }
__device__ __forceinline__ int v_rd_base(int lane) { return ((lane & 3) << 3) | (((lane >> 2) & 3) << 6) | (((lane >> 4) & 1) << 5) | (((lane >> 5) & 1) << 8); }
constexpr int v_rd_off(int d0, int ks, int half) { return d0 * 512 + ks * 4096 + half * 2048; }
template <int OFF> __device__ __forceinline__ s16x4 tr_read(int vb) {
    s16x4 r; asm volatile("ds_read_b64_tr_b16 %0, %1 offset:%2" : "=&v"(r) : "v"(vb), "i"(OFF) : "memory"); return r;
}
template <int D0> __device__ __forceinline__ void pv_one(f32x16& od, int vb, bf16x8 pa0, bf16x8 pa1, bf16x8 pa2, bf16x8 pa3) {
    const s16x4 l0 = tr_read<v_rd_off(D0, 0, 0)>(vb), h0 = tr_read<v_rd_off(D0, 0, 1)>(vb), l1 = tr_read<v_rd_off(D0, 1, 0)>(vb), h1 = tr_read<v_rd_off(D0, 1, 1)>(vb);
    const s16x4 l2 = tr_read<v_rd_off(D0, 2, 0)>(vb), h2 = tr_read<v_rd_off(D0, 2, 1)>(vb), l3 = tr_read<v_rd_off(D0, 3, 0)>(vb), h3 = tr_read<v_rd_off(D0, 3, 1)>(vb);
    asm volatile("s_waitcnt lgkmcnt(0)" ::: "memory"); SBAR();
#define PK(L, H) (bf16x8){L[0], L[1], L[2], L[3], H[0], H[1], H[2], H[3]}
    od = __builtin_amdgcn_mfma_f32_32x32x16_bf16(pa0, PK(l0, h0), od, 0, 0, 0);
    od = __builtin_amdgcn_mfma_f32_32x32x16_bf16(pa1, PK(l1, h1), od, 0, 0, 0);
    od = __builtin_amdgcn_mfma_f32_32x32x16_bf16(pa2, PK(l2, h2), od, 0, 0, 0);
    od = __builtin_amdgcn_mfma_f32_32x32x16_bf16(pa3, PK(l3, h3), od, 0, 0, 0);
#undef PK
}
__device__ __forceinline__ void pv_d0(f32x16* o, int vb, bf16x8 pa0, bf16x8 pa1, bf16x8 pa2, bf16x8 pa3) {
    pv_one<0>(o[0], vb, pa0, pa1, pa2, pa3); pv_one<1>(o[1], vb, pa0, pa1, pa2, pa3); pv_one<2>(o[2], vb, pa0, pa1, pa2, pa3); pv_one<3>(o[3], vb, pa0, pa1, pa2, pa3);
}
template <int XD, int SDEPTH, int LDQ>
__device__ __forceinline__ void attn_body(const bf16_t* __restrict__ Qb, const bf16_t* __restrict__ Kh, const bf16_t* __restrict__ Vh, const bf16_t* __restrict__ Kx,
                                          bf16_t* __restrict__ Yb, int seq, char* lds, const float SCALE) {
    const int tid = tid_l(), wid = tid >> 6, lane = tid & 63, r32 = lane & 31, hi = lane >> 5;
    char* V_lds = lds; char* K_lds = lds + 2 * A_SHM_V; char* X_lds = lds + 2 * A_SHM_V + 2 * A_SHM_K;
    float* wsf = (float*)(lds + 2 * A_SHM_V + 2 * A_SHM_K + 2 * A_SHM_X) + wid * 64; float* li_l = wsf; float* al_l = wsf + 32;
    float m_reg = -1e30f, l_reg = 0; f32x16 o[4] = {}; bf16x8 qr[8]; bf16x8 qx[XD > 0 ? XD / 16 : 1];
    const bf16_t* Qw = Qb + (long)(wid * 32 + r32) * LDQ + hi * 8;
#pragma unroll
    for (int d0 = 0; d0 < 8; ++d0) qr[d0] = *reinterpret_cast<const bf16x8*>(Qw + d0 * 16);
    if constexpr (XD > 0) {
#pragma unroll
        for (int d0 = 0; d0 < XD / 16; ++d0) qx[d0] = *reinterpret_cast<const bf16x8*>(Qw + 128 + d0 * 16);
    }
    const int sr = tid >> 4, sc = (tid & 15) * 8, vst0 = v_st(sr, sc), vst1 = v_st(32 + sr, sc);
    const int xr = tid >> 3, xc = (tid & 7) * 8;
    const int vb0 = (int)(uintptr_t)V_lds + v_rd_base(lane);
    struct { bf16x8 vs0, vs1, ks0, ks1, xs; } sr_[SDEPTH];
#define SLOAD(i, k0) do { sr_[i].vs0 = *(const bf16x8*)(&Vh[(long)((k0) + sr) * 128 + sc]); sr_[i].vs1 = *(const bf16x8*)(&Vh[(long)((k0) + 32 + sr) * 128 + sc]); \
    sr_[i].ks0 = *(const bf16x8*)(&Kh[(long)((k0) + sr) * 128 + sc]); sr_[i].ks1 = *(const bf16x8*)(&Kh[(long)((k0) + 32 + sr) * 128 + sc]); \
    if constexpr (XD > 0) sr_[i].xs = *(const bf16x8*)(&Kx[(long)((k0) + xr) * 64 + xc]); } while (0)
#define SWRITE(b, i) do { *(bf16x8*)(V_lds + (b) * A_SHM_V + vst0) = sr_[i].vs0;          \
    *(bf16x8*)(V_lds + (b) * A_SHM_V + vst1) = sr_[i].vs1; int kc = sc * 2;               \
    *(bf16x8*)(K_lds + (b) * A_SHM_K + KSWZ(sr, kc)) = sr_[i].ks0;                       \
    *(bf16x8*)(K_lds + (b) * A_SHM_K + KSWZ(32 + sr, kc)) = sr_[i].ks1;                  \
    if constexpr (XD > 0) *(bf16x8*)(X_lds + (b) * A_SHM_X + XSWZ(xr, xc * 2)) = sr_[i].xs; } while (0)
#define SWAIT() do { if constexpr (SDEPTH == 2) { if constexpr (XD > 0) asm volatile("s_waitcnt vmcnt(5)" ::: "memory"); else asm volatile("s_waitcnt vmcnt(4)" ::: "memory"); } \
    else asm volatile("s_waitcnt vmcnt(0)" ::: "memory"); } while (0)
#define RESC(a) do { if (__any((a) < 1.f)) { if (hi == 0) al_l[r32] = (a); asm volatile("s_waitcnt lgkmcnt(0)" ::: "memory"); \
    _Pragma("unroll") for (int d = 0; d < 4; ++d) _Pragma("unroll") for (int r = 0; r < 16; ++r) o[d][r] *= al_l[crow(r, hi)]; } } while (0)
    f32x16 pA0, pA1, pB0, pB1; float mnA, mnB, alA, alB; bf16x8 pa0, pa1, pa2, pa3; const int NT = seq / 64;
    constexpr int SE = 0, SO = SDEPTH - 1;
    SLOAD(SE, 0); asm volatile("s_waitcnt vmcnt(0)" ::: "memory"); SWRITE(0, SE); __syncthreads();
    qkt<XD>(pA0, pA1, K_lds, X_lds, qr, qx, r32, hi); partialSM(pA0, pA1, m_reg, mnA, alA, SCALE);
    SLOAD(SO, 64); if constexpr (SDEPTH == 2) { if (2 < NT) SLOAD(SE, 2 * 64); }
    SWAIT(); SWRITE(1, SO); __syncthreads();
    for (int j = 1; j + 1 < NT; j += 2) {
        SBAR(); qkt<XD>(pB0, pB1, K_lds + A_SHM_K, X_lds + A_SHM_X, qr, qx, r32, hi);
        finishSM(pA0, pA1, alA, l_reg, pa0, pa1, pa2, pa3); SBAR();
        SLOAD(SO, (j + SDEPTH) * 64); SBAR();
        pv_d0(o, vb0, pa0, pa1, pa2, pa3); partialSM(pB0, pB1, m_reg, mnB, alB, SCALE);
        __syncthreads(); SWAIT(); SWRITE(0, SE);
        RESC(alB); __syncthreads();
        SBAR(); qkt<XD>(pA0, pA1, K_lds, X_lds, qr, qx, r32, hi);
        finishSM(pB0, pB1, alB, l_reg, pa0, pa1, pa2, pa3); SBAR();
        if (SDEPTH == 1 || j + 3 < NT) SLOAD(SE, (j + 1 + SDEPTH) * 64); SBAR();
        pv_d0(o, vb0 + A_SHM_V, pa0, pa1, pa2, pa3); partialSM(pA0, pA1, m_reg, mnA, alA, SCALE);
        __syncthreads(); SWAIT(); SWRITE(1, SO);
        RESC(alA); __syncthreads();
    }
    SBAR(); qkt<XD>(pB0, pB1, K_lds + A_SHM_K, X_lds + A_SHM_X, qr, qx, r32, hi);
    finishSM(pA0, pA1, alA, l_reg, pa0, pa1, pa2, pa3); SBAR();
    pv_d0(o, vb0, pa0, pa1, pa2, pa3); partialSM(pB0, pB1, m_reg, mnB, alB, SCALE);
    __syncthreads(); RESC(alB);
    finishSM(pB0, pB1, alB, l_reg, pa0, pa1, pa2, pa3); SBAR();
    pv_d0(o, vb0 + A_SHM_V, pa0, pa1, pa2, pa3);
    if (hi == 0) li_l[r32] = l_reg; asm volatile("s_waitcnt lgkmcnt(0)" ::: "memory");
    float rli[16];
#pragma unroll
    for (int r = 0; r < 16; ++r) rli[r] = __builtin_amdgcn_rcpf(li_l[crow(r, hi)]);
    bf16_t* Yw = Yb + (long)(wid * 32) * 2048;
#pragma unroll
    for (int r = 0; r < 16; ++r) { const int orow = crow(r, hi);
#pragma unroll
        for (int d0 = 0; d0 < 4; ++d0) { bf16_t* yp = Yw + (long)orow * 2048 + d0 * 32 + r32; *yp = f2bf(o[d0][r] * rli[r] * bf2f(*yp)); } }
    __syncthreads();
#undef SLOAD
#undef SWRITE
#undef SWAIT
#undef RESC
}

__device__ __forceinline__ void tconv_tile(const float* src, int ld, int k0, int sc0, bf16_t* dst, int ldd, int n0, float* tile) {
    const int tid = tid_l();
#pragma unroll
    for (int i = 0; i < 2; ++i) { const int r = (tid >> 4) + 32 * i, c = (tid & 15) * 4;
        f32x4 v = {0.f, 0.f, 0.f, 0.f}; if (sc0 >= 0) v = *(const f32x4*)(src + (size_t)(k0 + r) * ld + sc0 + c);
        tile[r * 65 + c] = v[0]; tile[r * 65 + c + 1] = v[1]; tile[r * 65 + c + 2] = v[2]; tile[r * 65 + c + 3] = v[3]; }
    __syncthreads();
    { const int n = tid >> 3, k8 = (tid & 7) * 8; float v[8];
#pragma unroll
      for (int j = 0; j < 8; ++j) v[j] = tile[(k8 + j) * 65 + n];
      *(u32x4*)(dst + (size_t)(n0 + n) * ldd + k0 + k8) = pack8(v); }
    __syncthreads();
}
__device__ __forceinline__ int wi_src(int n0) {
    if (n0 < 1280) return n0;
    if (n0 < 2304) return 1344 + (n0 - 1280);
    if (n0 < 2560) return 2368 + (n0 - 2304);
    if (n0 < 2816) return 2624 + (n0 - 2560);
    if (n0 < 2880) return 1280 + (n0 - 2816);
    if (n0 < 3072) return -1;
    return 2880 + (n0 - 3072);
}

__device__ __forceinline__ void phase_prep(const Params& p, float* ldsf) {
    const int tid = tid_l(), G = gridDim.x, bid = blockIdx.x, lane = tid & 63, wid = tid >> 6;
    unsigned char* ws = p.ws;
    float* sv = ldsf; float* red = ldsf + 3 * 2048;
    for (int i = tid; i < 3 * 2048; i += 512) { const int vec = i >> 11, k = i & 2047; const float v = vec < 2 ? p.c[vec * 2048 + k] : p.c_ctx[k]; sv[i] = silu(v); }
    __syncthreads();
    float* mod = (float*)(ws + OFF_MOD);
    for (int unit = bid; unit < 384; unit += G) {
        const int layer = unit / 192, col0 = (unit % 192) * 32, kc = tid >> 3, c4 = (tid & 7) * 4;
        const float* W = p.ada_w + (size_t)layer * 2048 * 6144 + col0 + c4;
        f32x4 a0 = {0, 0, 0, 0}, a1 = a0, a2 = a0;
#pragma unroll 4
        for (int i = 0; i < 32; ++i) { const int k = kc + 64 * i; const f32x4 w = *(const f32x4*)(W + (size_t)k * 6144);
            a0 += w * sv[k]; a1 += w * sv[2048 + k]; a2 += w * sv[4096 + k]; }
#pragma unroll
        for (int j = 0; j < 4; ++j) {
#pragma unroll
            for (int o = 8; o < 64; o <<= 1) { a0[j] += __shfl_xor(a0[j], o); a1[j] += __shfl_xor(a1[j], o); a2[j] += __shfl_xor(a2[j], o); } }
        if (lane < 8) {
#pragma unroll
            for (int j = 0; j < 4; ++j) { red[(wid * 3 + 0) * 32 + c4 + j] = a0[j]; red[(wid * 3 + 1) * 32 + c4 + j] = a1[j]; red[(wid * 3 + 2) * 32 + c4 + j] = a2[j]; } }
        __syncthreads();
        if (tid < 96) { const int vec = tid >> 5, cc = tid & 31; float s = 0;
#pragma unroll
            for (int w = 0; w < 8; ++w) s += red[(w * 3 + vec) * 32 + cc];
            mod[(layer * 3 + vec) * 6144 + col0 + cc] = s + p.ada_b[layer * 6144 + col0 + cc]; }
        __syncthreads();
    }
    __syncthreads();
    float* tile = ldsf;
    for (int T = bid; T < 8224; T += G) {
        int t = T;
        if (t < 2560) { const int kt = t & 31, nt = t >> 5; tconv_tile(p.w_in_attn, 4928, kt * 64, wi_src(nt * 64), (bf16_t*)(ws + OFF_WI), 2048, nt * 64, tile); continue; }
        t -= 2560;
        if (t < 288) { const int kt = t % 12, nt = t / 12; tconv_tile(p.wq_b, 1536, kt * 64, nt * 64, (bf16_t*)(ws + OFF_WQ), 768, nt * 64, tile); continue; }
        t -= 288;
        if (t < 256) { const int kt = t & 7, nt = t >> 3; tconv_tile(p.wkv_b, 2048, kt * 64, nt * 64, (bf16_t*)(ws + OFF_WKV), 512, nt * 64, tile); continue; }
        t -= 256;
        if (t < 1024) { const int kt = t & 31, nt = t >> 5; tconv_tile(p.w_out_attn, 2048, kt * 64, nt * 64, (bf16_t*)(ws + OFF_WO), 2048, nt * 64, tile); continue; }
        t -= 1024;
        if (t < 2048) { const int kt = t & 31, nt = t >> 5; tconv_tile(p.w_in_f, 8192, kt * 64, 4096 + nt * 64, (bf16_t*)(ws + OFF_WFG), 2048, nt * 64, tile); continue; }
        t -= 2048;
        { const int kt = t & 63, nt = t >> 6; tconv_tile(p.w_out_f, 2048, kt * 64, nt * 64, (bf16_t*)(ws + OFF_WOF), 4096, nt * 64, tile); }
    }
    { bf16_t* Wub = (bf16_t*)(ws + OFF_WUB);
      for (int i = bid * 512 + tid; i < 2048 * 512; i += G * 512) { const int k = i >> 9, c8 = (i & 511) * 8;
          const f32x4 a = *(const f32x4*)(p.w_in_f + (size_t)k * 8192 + c8), b = *(const f32x4*)(p.w_in_f + (size_t)k * 8192 + c8 + 4);
          float v[8] = {a[0], a[1], a[2], a[3], b[0], b[1], b[2], b[3]}; *(u32x4*)(Wub + (size_t)k * 4096 + c8) = pack8(v); } }
    { bf16_t* Tt = (bf16_t*)(ws + OFF_TT);
      for (int i = bid * 512 + tid; i < 65536; i += G * 512) { const int j = i >> 8, n2 = i & 255; const int jj = j <= 128 ? j : j - 128;
          const float rev = (float)((jj * n2) & 255) * (1.f / 256.f); const float v = (j <= 128 ? cos_rev(rev) : sin_rev(rev)) * 0.0625f; Tt[i] = f2bf(v); } }
    { bf16_t* Tr = (bf16_t*)(ws + OFF_TRIG);
      for (int i = bid * 512 + tid; i < 1024 * 2048; i += G * 512) { const int m = i >> 11, n = i & 2047, np = n & 1023;
          const float rev = (float)((m * np) & 1023) * (1.f / 1024.f); Tr[i] = f2bf(n < 1024 ? cos_rev(rev) : sin_rev(rev)); } }
}

__device__ __forceinline__ void row_stats(const f32x4 (&v)[8], float& mean, float& rstd) {
    float s = 0;
#pragma unroll
    for (int i = 0; i < 8; ++i) s += v[i][0] + v[i][1] + v[i][2] + v[i][3];
    mean = wave_sum(s) * (1.f / 2048.f);
    float q = 0;
#pragma unroll
    for (int i = 0; i < 8; ++i) { const f32x4 d = v[i] - mean; q += d[0] * d[0] + d[1] * d[1] + d[2] * d[2] + d[3] * d[3]; }
    rstd = rsqrtf(wave_sum(q) * (1.f / 2048.f) + 1e-6f);
}
__device__ __forceinline__ void mod_store(const f32x4 (&v)[8], float mean, float rstd, const float* shift, const float* scale, bf16_t* hr, int lane) {
#pragma unroll
    for (int i = 0; i < 8; ++i) { const int c = i * 256 + lane * 4; const f32x4 sc = *(const f32x4*)(scale + c), sh = *(const f32x4*)(shift + c);
        const f32x4 y = (v[i] - mean) * rstd * (sc + 1.f) + sh; u32x2 w; w.x = cvtpk(y[0], y[1]); w.y = cvtpk(y[2], y[3]); *(u32x2*)(hr + c) = w; }
}

__device__ __forceinline__ void phase_ln0(const Params& p) {
    const int tid = tid_l(), lane = tid & 63, wid = tid >> 6, G = gridDim.x;
    const float* mod = (const float*)(p.ws + OFF_MOD); bf16_t* H = (bf16_t*)(p.ws + OFF_H);
    for (int r = blockIdx.x * 8 + wid; r < NTOK; r += G * 8) {
        const float* xr; int vec;
        if (r < NLAT) { xr = p.x + (size_t)r * DM; vec = r >> 13; } else { xr = p.ctx + (size_t)(r - NLAT) * DM; vec = 2; }
        f32x4 v[8];
#pragma unroll
        for (int i = 0; i < 8; ++i) v[i] = *(const f32x4*)(xr + i * 256 + lane * 4);
        float mean, rstd; row_stats(v, mean, rstd);
        mod_store(v, mean, rstd, mod + vec * 6144, mod + vec * 6144 + 2048, H + (size_t)r * DM, lane);
    }
}
__device__ __forceinline__ void phase_fold(const Params& p, LAS unsigned char* lds) {
    for (int w = blockIdx.x; w < 128; w += gridDim.x) {
        const int g = w >> 3;
        pg8::Gemm gm{(const bf16_t*)(p.ws + OFF_TT), (const bf16_t*)(p.ws + OFF_WUB) + g * 256, 256, 2048, 256, 256, 4096};
        pg8::OneUnit S{0, w & 7};
        pg8::EpiB<FStore> E{FStore{(bf16_t*)(p.ws + OFF_WFU) + (size_t)g * 256 * 2048, 2048}};
        pg8::gemm_phase(lds, gm, S, E);
    }
}

__device__ __forceinline__ void phase_postz(const Params& p) {
    const int tid = tid_l(), lane = tid & 63, wid = tid >> 6, G = gridDim.x;
    unsigned char* ws = p.ws;
    const bf16_t* Z = (const bf16_t*)(ws + OFF_Z);
    bf16_t* CQN = (bf16_t*)(ws + OFF_CQN); bf16_t* CKVN = (bf16_t*)(ws + OFF_CKVN); bf16_t* QB = (bf16_t*)(ws + OFF_QB);
    bf16_t* KB = (bf16_t*)(ws + OFF_KB); bf16_t* VB = (bf16_t*)(ws + OFF_VB); bf16_t* KPE = (bf16_t*)(ws + OFF_KPE);
    for (int r = blockIdx.x * 8 + wid; r < NTOK; r += G * 8) {
        const bf16_t* zr = Z + (size_t)r * ZW; const bool lat = r < NLAT; int b, pos, s;
        if (lat) { b = r >> 13; s = r & (SEQ - 1); pos = CTX + s; } else { const int cr = r - NLAT; b = cr >> 8; pos = cr & 255; s = 0; }
        const float prow = (float)(s >> 6), pcol = (float)(s & 63);
        float v[8];
        if (lat) {
            float v2[8]; unpack8(*(const u32x4*)(zr + lane * 8), v); float ss = 0;
#pragma unroll
            for (int j = 0; j < 8; ++j) ss += v[j] * v[j];
            if (lane < 32) { unpack8(*(const u32x4*)(zr + 512 + lane * 8), v2);
#pragma unroll
                for (int j = 0; j < 8; ++j) ss += v2[j] * v2[j]; }
            const float rstd = rsqrtf(wave_sum(ss) * (1.f / 768.f) + 1e-6f);
#pragma unroll
            for (int j = 0; j < 8; ++j) v[j] = v[j] * rstd * p.q_lora_g[lane * 8 + j];
            *(u32x4*)(CQN + (size_t)r * 768 + lane * 8) = pack8(v);
            if (lane < 32) {
#pragma unroll
                for (int j = 0; j < 8; ++j) v2[j] = v2[j] * rstd * p.q_lora_g[512 + lane * 8 + j];
                *(u32x4*)(CQN + (size_t)r * 768 + 512 + lane * 8) = pack8(v2); }
        }
        {
            unpack8(*(const u32x4*)(zr + 768 + lane * 8), v); float ss = 0;
#pragma unroll
            for (int j = 0; j < 8; ++j) ss += v[j] * v[j];
            const float rstd = rsqrtf(wave_sum(ss) * (1.f / 512.f) + 1e-6f);
#pragma unroll
            for (int j = 0; j < 8; ++j) v[j] = v[j] * rstd * p.kv_lora_g[lane * 8 + j];
            *(u32x4*)(CKVN + (size_t)r * 512 + lane * 8) = pack8(v);
        }
        const int d = (lane & 15) * 8;
        if (lat) {
#pragma unroll
            for (int ps = 0; ps < 2; ++ps) {
                unpack8(*(const u32x4*)(zr + 1280 + ps * 512 + lane * 8), v); float ss = 0;
#pragma unroll
                for (int j = 0; j < 8; ++j) ss += v[j] * v[j];
                const float rstd = rsqrtf(sum16(ss) * (1.f / 128.f) + 1e-6f);
#pragma unroll
                for (int j = 0; j < 8; ++j) v[j] = v[j] * rstd * p.qn_g[d + j];
                rope8(v, d >> 1, 32, prow, pcol);
                *(u32x4*)(QB + (size_t)r * 1024 + ps * 512 + lane * 8) = pack8(v);
            }
        }
        {
            unpack8(*(const u32x4*)(zr + 2304 + lane * 8), v); float ss = 0;
#pragma unroll
            for (int j = 0; j < 8; ++j) ss += v[j] * v[j];
            const float rstd = rsqrtf(sum16(ss) * (1.f / 128.f) + 1e-6f);
            const int head = (lane >> 4) & 1; const bool isV = lane >= 32;
            if (!isV) {
#pragma unroll
                for (int j = 0; j < 8; ++j) v[j] = v[j] * rstd * p.kn_g[d + j];
                if (lat) rope8(v, d >> 1, 32, prow, pcol);
            }
            bf16_t* dst = (isV ? VB : KB) + ((size_t)((b * 2 + head) * LKV + pos) * 128 + d);
            *(u32x4*)dst = pack8(v);
        }
        if (lane < 8) {
            unpack8(*(const u32x4*)(zr + 2816 + lane * 8), v);
            if (lat) rope8(v, lane * 4, 16, prow, pcol);
            *(u32x4*)(KPE + (size_t)(b * LKV + pos) * 64 + lane * 8) = pack8(v);
        }
    }
}

__device__ __forceinline__ void phase_ln1(const Params& p) {
    const int tid = tid_l(), lane = tid & 63, wid = tid >> 6, G = gridDim.x;
    const float* mod1 = (const float*)(p.ws + OFF_MOD) + 3 * 6144; bf16_t* H1 = (bf16_t*)(p.ws + OFF_H1);
    for (int r = blockIdx.x * 8 + wid; r < NLAT; r += G * 8) {
        float* xr = p.out + (size_t)r * DM; const int vec = r >> 13;
        f32x4 v[8];
#pragma unroll
        for (int i = 0; i < 8; ++i) v[i] = *(const f32x4*)(xr + i * 256 + lane * 4);
        float mean, rstd; row_stats(v, mean, rstd);
#pragma unroll
        for (int i = 0; i < 8; ++i) { const int c = i * 256 + lane * 4; const f32x4 g = *(const f32x4*)(p.ln_g + c), bb = *(const f32x4*)(p.ln_b + c);
            v[i] = (v[i] - mean) * rstd * g + bb; *(f32x4*)(xr + c) = v[i]; }
        row_stats(v, mean, rstd);
        mod_store(v, mean, rstd, mod1 + vec * 6144, mod1 + vec * 6144 + 2048, H1 + (size_t)r * DM, lane);
    }
}
__device__ __forceinline__ void phase_ln2(const Params& p) {
    const int tid = tid_l(), lane = tid & 63, wid = tid >> 6, G = gridDim.x;
    for (int r = blockIdx.x * 8 + wid; r < NLAT; r += G * 8) {
        float* xr = p.out + (size_t)r * DM;
        f32x4 v[8];
#pragma unroll
        for (int i = 0; i < 8; ++i) v[i] = *(const f32x4*)(xr + i * 256 + lane * 4);
        float mean, rstd; row_stats(v, mean, rstd);
#pragma unroll
        for (int i = 0; i < 8; ++i) { const int c = i * 256 + lane * 4; const f32x4 g = *(const f32x4*)(p.ln_g + DM + c), bb = *(const f32x4*)(p.ln_b + DM + c);
            *(f32x4*)(xr + c) = (v[i] - mean) * rstd * g + bb; }
    }
}

__device__ __forceinline__ void phase_radix8(const Params& p) {
    const int tid = tid_l(), G = gridDim.x;
    const bf16_t* PT = (const bf16_t*)(p.ws + OFF_PT); bf16_t* ZS = (bf16_t*)(p.ws + OFF_ZS);
    for (int u = blockIdx.x; u < 4128; u += G) {
        int bg, k2; if (u < 4096) { bg = u >> 7; k2 = u & 127; } else { bg = u - 4096; k2 = 128; }
        const int b = bg >> 4, g = bg & 15;
        const bf16_t* Pp = PT + (size_t)(g * 256 + k2) * NLAT + b * SEQ + 2 * tid;
        const bool hasQ = (k2 >= 1 && k2 <= 127);
        const bf16_t* Qp = PT + (size_t)(g * 256 + 128 + k2) * NLAT + b * SEQ + 2 * tid;
        float zr[8][2], zi[8][2];
#pragma unroll
        for (int q = 0; q < 8; ++q) { const unsigned w = *(const unsigned*)(Pp + 1024 * q); zr[q][0] = bflo(w); zr[q][1] = bfhi(w);
            if (hasQ) { const unsigned w2 = *(const unsigned*)(Qp + 1024 * q); zi[q][0] = -bflo(w2); zi[q][1] = -bfhi(w2); } else { zi[q][0] = 0.f; zi[q][1] = 0.f; } }
        constexpr float R = 0.70710678118654752f;
        constexpr float CK[8] = {1.f, R, 0.f, -R, -1.f, -R, 0.f, R}, SK[8] = {0.f, R, 1.f, R, 0.f, -R, -1.f, -R};
#pragma unroll
        for (int s = 0; s < 8; ++s) {
            float yr[2] = {0.f, 0.f}, yi[2] = {0.f, 0.f};
#pragma unroll
            for (int q = 0; q < 8; ++q) { const float ck = CK[(s * q) & 7], sk = SK[(s * q) & 7];
#pragma unroll
                for (int e = 0; e < 2; ++e) { yr[e] += zr[q][e] * ck + zi[q][e] * sk; yi[e] += zi[q][e] * ck - zr[q][e] * sk; } }
            float a[2], bq[2];
#pragma unroll
            for (int e = 0; e < 2; ++e) { const float rev = (float)(s * (2 * tid + e)) * (1.f / 8192.f); const float cs = cos_rev(rev), sn = sin_rev(rev);
                a[e] = yr[e] * cs + yi[e] * sn; bq[e] = yi[e] * cs - yr[e] * sn; }
            const size_t rho = (u < 4096) ? (size_t)((bg * 8 + s) * 128 + k2) : (size_t)(32768 + bg * 8 + s);
            *(unsigned*)(ZS + rho * 2048 + 2 * tid) = cvtpk(a[0], a[1]);
            *(unsigned*)(ZS + rho * 2048 + 1024 + 2 * tid) = cvtpk(bq[0], bq[1]);
        }
    }
}

__device__ __forceinline__ void phase_combine(const Params& p) {
    const int tid = tid_l(), lane = tid & 63, wid = tid >> 6, G = gridDim.x;
    const bf16_t* XR = (const bf16_t*)(p.ws + OFF_XR); const bf16_t* XR128 = (const bf16_t*)(p.ws + OFF_XR128); bf16_t* SG = (bf16_t*)(p.ws + OFF_SG);
    constexpr float NRM = 0.011048543456039806f;
    for (int r = blockIdx.x * 8 + wid; r < NLAT; r += G * 8) {
        const int b = r >> 13, k1 = r & (SEQ - 1), rm = b * SEQ + ((SEQ - k1) & (SEQ - 1));
        const bf16_t* x0 = XR + (size_t)r * 2048; const bf16_t* xm = XR + (size_t)rm * 2048; bf16_t* sg = SG + (size_t)r * 4096;
#pragma unroll
        for (int it = 0; it < 8; ++it) {
            const int c0 = (it * 64 + lane) * 8, g = c0 >> 8, k20 = c0 & 255;
            float f[8], gt[8]; unpack8(*(const u32x4*)(sg + c0), gt);
            if (k20 < 128) unpack8(*(const u32x4*)(x0 + g * 128 + k20), f);
            else {
#pragma unroll
                for (int j = 0; j < 8; ++j) { const int k2 = k20 + j; f[j] = (k2 == 128) ? bf2f(XR128[(size_t)r * 16 + g]) : bf2f(xm[g * 128 + 256 - k2]); } }
#pragma unroll
            for (int j = 0; j < 8; ++j) f[j] = f[j] * NRM * gt[j];
            *(u32x4*)(sg + c0) = pack8(f);
        }
    }
}

__global__ __launch_bounds__(512) void mega(Params p) {
    extern __shared__ __attribute__((aligned(16))) unsigned char shm[];
    cg::grid_group grid = cg::this_grid();
    LAS unsigned char* lds = (LAS unsigned char*)shm;
    unsigned char* ws = p.ws;
    const int G = gridDim.x, bid = blockIdx.x;
    const float* mod = (const float*)(ws + OFF_MOD);
    for (int ph = p.ph_lo; ph < p.ph_hi; ++ph) {
        if (PH_ON(0) && ph == 0) phase_prep(p, (float*)shm);
        else if (PH_ON(1) && ph == 1) { phase_ln0(p); phase_fold(p, lds); }
        else if (PH_ON(2) && ph == 2) {
            pg8::Gemm gm{(const bf16_t*)(ws + OFF_H), (const bf16_t*)(ws + OFF_WI), NTOK, NWI, 2048, 2048, 2048};
            pg8::StaticOrder S; S.init(gm.M, gm.N, G, bid);
            pg8::EpiB<FZ> E{FZ{(bf16_t*)(ws + OFF_Z), (bf16_t*)(ws + OFF_SG0)}};
            pg8::gemm_phase(lds, gm, S, E);
        }
        else if (PH_ON(3) && ph == 3) phase_postz(p);
        else if (PH_ON(4) && ph == 4) {
            { pg8::Gemm gm{(const bf16_t*)(ws + OFF_CQN), (const bf16_t*)(ws + OFF_WQ), NLAT, 1536, 768, 768, 768};
              pg8::StaticOrder S; S.init(gm.M, gm.N, G, bid);
              pg8::EpiB<FQa> E{FQa{(bf16_t*)(ws + OFF_QA)}};
              pg8::gemm_phase(lds, gm, S, E); }
            { pg8::Gemm gm{(const bf16_t*)(ws + OFF_CKVN), (const bf16_t*)(ws + OFF_WKV), NTOK, 2048, 512, 512, 512};
              pg8::StaticOrder S; S.init(gm.M, gm.N, G, bid);
              pg8::EpiB<FKva> E{FKva{(bf16_t*)(ws + OFF_KA), (bf16_t*)(ws + OFF_VA)}};
              pg8::gemm_phase(lds, gm, S, E); }
        }
        else if (PH_ON(5) && ph == 5) {
            bf16_t* Y = (bf16_t*)(ws + OFF_SG0);
            for (int u = bid; u < 256; u += G) {
                const int head = u & 7, qblk = u >> 3;
                for (int b = 0; b < NB; ++b) {
                    const size_t t0 = (size_t)b * SEQ + qblk * 256;
                    attn_body<64, 1, 1536>((const bf16_t*)(ws + OFF_QA) + t0 * 1536 + head * 192,
                                           (const bf16_t*)(ws + OFF_KA) + (size_t)(b * 8 + head) * LKV * 128, (const bf16_t*)(ws + OFF_VA) + (size_t)(b * 8 + head) * LKV * 128,
                                           (const bf16_t*)(ws + OFF_KPE) + (size_t)b * LKV * 64, Y + t0 * 2048 + head * 128, LKV, (char*)shm, 0.07216878364870322f);
                }
                for (int b = 0; b < NB; ++b) {
                    const size_t t0 = (size_t)b * SEQ + qblk * 256; const int kvh = head >> 2;
                    attn_body<0, 2, 1024>((const bf16_t*)(ws + OFF_QB) + t0 * 1024 + head * 128,
                                          (const bf16_t*)(ws + OFF_KB) + (size_t)(b * 2 + kvh) * LKV * 128, (const bf16_t*)(ws + OFF_VB) + (size_t)(b * 2 + kvh) * LKV * 128,
                                          nullptr, Y + t0 * 2048 + 1024 + head * 128, LKV, (char*)shm, 0.08838834764831845f);
                }
            }
        }
        else if (PH_ON(6) && ph == 6) {
            pg8::Gemm gm{(const bf16_t*)(ws + OFF_SG0), (const bf16_t*)(ws + OFF_WO), NLAT, 2048, 2048, 2048, 2048};
            pg8::StaticOrder S; S.init(gm.M, gm.N, G, bid);
            pg8::EpiF<FRes> E{FRes{p.x, mod + 4096, p.out}};
            pg8::gemm_phase(lds, gm, S, E);
        }
        else if (PH_ON(7) && ph == 7) phase_ln1(p);
        else if (PH_ON(8) && ph == 8) {
            { pg8::Gemm gm{(const bf16_t*)(ws + OFF_WFU), (const bf16_t*)(ws + OFF_H1), 4096, NLAT, 2048, 2048, 2048};
              pg8::StaticOrder S; S.init(gm.M, gm.N, G, bid);
              pg8::EpiB<FStore> E{FStore{(bf16_t*)(ws + OFF_PT), NLAT}};
              pg8::gemm_phase(lds, gm, S, E); }
            { pg8::Gemm gm{(const bf16_t*)(ws + OFF_H1), (const bf16_t*)(ws + OFF_WFG), NLAT, 4096, 2048, 2048, 2048};
              pg8::StaticOrder S; S.init(gm.M, gm.N, G, bid);
              pg8::EpiB<FSilu> E{FSilu{(bf16_t*)(ws + OFF_SG), 4096}};
              pg8::gemm_phase(lds, gm, S, E); }
        }
        else if (PH_ON(9) && ph == 9) phase_radix8(p);
        else if (PH_ON(10) && ph == 10) {
            pg8::Gemm gm{(const bf16_t*)(ws + OFF_TRIG), (const bf16_t*)(ws + OFF_ZS), 1024, NZS, 2048, 2048, 2048};
            pg8::StaticOrder S; S.init(gm.M, gm.N, G, bid);
            pg8::EpiB<FXr> E{FXr{(bf16_t*)(ws + OFF_XR), (bf16_t*)(ws + OFF_XR128)}};
            pg8::gemm_phase(lds, gm, S, E);
        }
        else if (PH_ON(11) && ph == 11) phase_combine(p);
        else if (PH_ON(12) && ph == 12) {
            pg8::Gemm gm{(const bf16_t*)(ws + OFF_SG), (const bf16_t*)(ws + OFF_WOF), NLAT, 2048, 4096, 4096, 4096};
            pg8::StaticOrder S; S.init(gm.M, gm.N, G, bid);
            pg8::EpiF<FRes> E{FRes{p.out, mod + 3 * 6144 + 4096, p.out}};
            pg8::gemm_phase(lds, gm, S, E);
        }
        else if (PH_ON(13) && ph == 13) phase_ln2(p);
        if (ph + 1 < p.ph_hi) grid.sync();
    }
}

extern "C" void kernel_launch(void* const* d_in, const int* in_sizes, int n_in, void* d_out, int out_size, void* d_ws, size_t ws_size, hipStream_t stream) {
    static int grid = 0;
    if (grid == 0) {
        if (n_in != 18 || in_sizes[0] != NLAT * DM || out_size != NLAT * DM || ws_size < WS_NEED) {
            fprintf(stderr, "kernel_launch: shape/workspace mismatch (n_in %d, in0 %d, out %d, ws %zu, need %zu)\n", n_in, n_in > 0 ? in_sizes[0] : -1, out_size, ws_size, (size_t)WS_NEED); grid = -1; return; }
        int dev = 0, cus = 0, per_cu = 0;
        hipGetDevice(&dev); hipDeviceGetAttribute(&cus, hipDeviceAttributeMultiprocessorCount, dev);
        if (hipFuncSetAttribute((const void*)mega, hipFuncAttributeMaxDynamicSharedMemorySize, LDS_BYTES) != hipSuccess) { fprintf(stderr, "kernel_launch: hipFuncSetAttribute failed\n"); grid = -1; return; }
        if (hipOccupancyMaxActiveBlocksPerMultiprocessor(&per_cu, (const void*)mega, 512, LDS_BYTES) != hipSuccess || per_cu < 1) { fprintf(stderr, "kernel_launch: occupancy query says %d\n", per_cu); per_cu = 1; }
        (void)hipGetLastError();
        grid = cus * 1;
        if (grid > 256) grid = 256;
    }
    if (grid < 0) return;
    Params p{};
    p.x = (const float*)d_in[0]; p.c = (const float*)d_in[1]; p.ctx = (const float*)d_in[2]; p.c_ctx = (const float*)d_in[3]; p.ada_w = (const float*)d_in[4]; p.ada_b = (const float*)d_in[5];
    p.ln_g = (const float*)d_in[6]; p.ln_b = (const float*)d_in[7]; p.w_in_attn = (const float*)d_in[8]; p.wq_b = (const float*)d_in[9]; p.q_lora_g = (const float*)d_in[10];
    p.kv_lora_g = (const float*)d_in[11]; p.wkv_b = (const float*)d_in[12]; p.qn_g = (const float*)d_in[13]; p.kn_g = (const float*)d_in[14]; p.w_out_attn = (const float*)d_in[15];
    p.w_in_f = (const float*)d_in[16]; p.w_out_f = (const float*)d_in[17]; p.out = (float*)d_out; p.ws = (unsigned char*)d_ws;
#if MK_MULTI
    for (int ph = 0; ph < NPH; ++ph) { p.ph_lo = ph; p.ph_hi = ph + 1; hipLaunchKernelGGL(mega, dim3(grid), dim3(512), LDS_BYTES, stream, p); }
#else
    p.ph_lo = 0; p.ph_hi = NPH;
    void* args[] = {&p};
    hipError_t e = hipLaunchCooperativeKernel((const void*)mega, dim3(grid), dim3(512), args, LDS_BYTES, stream);
    if (e != hipSuccess) fprintf(stderr, "kernel_launch: cooperative launch failed: %s (grid %d)\n", hipGetErrorString(e), grid);
#endif
}
```

```cpp
#include <hip/hip_runtime.h>
#include <hip/hip_cooperative_groups.h>
#include <cstdio>
#include <cstdint>
namespace cg = cooperative_groups;

#ifndef MK_MULTI
#define MK_MULTI 0
#endif
#ifndef PHMASK
#define PHMASK 0xffff
#endif
#define PH_ON(n) ((PHMASK >> (n)) & 1)
#ifndef REP_PH
#define REP_PH -1
#endif

typedef unsigned short bf16_t;
typedef short bf16x8 __attribute__((ext_vector_type(8)));
typedef short s16x4 __attribute__((ext_vector_type(4)));
typedef float f32x4 __attribute__((ext_vector_type(4)));
typedef float f32x16 __attribute__((ext_vector_type(16)));
typedef unsigned u32x4 __attribute__((ext_vector_type(4)));
typedef unsigned u32x2 __attribute__((ext_vector_type(2)));
#define LAS __attribute__((address_space(3)))

constexpr int DM = 2048, NB = 2, SEQ = 8192, CTX = 256, NLAT = NB * SEQ, NTOK = NLAT + NB * CTX, LKV = SEQ + CTX;
constexpr int ZW = 3072;
constexpr int NWI = 5120;
constexpr float ALPHA = 1.4142135623730951f;
constexpr int NPH = 14;
constexpr int LDS_STAGE = 131072;
constexpr int LDS_BYTES = LDS_STAGE + 256;

constexpr size_t al256(size_t x) { return (x + 255) / 256 * 256; }
constexpr size_t OFF_WI = 0;
constexpr size_t OFF_WQ = OFF_WI + (size_t)NWI * 2048 * 2;
constexpr size_t OFF_WKV = OFF_WQ + (size_t)1536 * 768 * 2;
constexpr size_t OFF_WO = OFF_WKV + (size_t)2048 * 512 * 2;
constexpr size_t OFF_WFU = OFF_WO + (size_t)2048 * 2048 * 2;
constexpr size_t OFF_WFG = OFF_WFU + (size_t)4096 * 2048 * 2;
constexpr size_t OFF_WOF = OFF_WFG + (size_t)4096 * 2048 * 2;
constexpr size_t OFF_WUB = OFF_WOF + (size_t)2048 * 4096 * 2;
constexpr size_t OFF_TT = OFF_WUB + (size_t)2048 * 4096 * 2;
constexpr size_t OFF_TRIG = OFF_TT + (size_t)256 * 256 * 2;
constexpr size_t OFF_MOD = OFF_TRIG + (size_t)1024 * 2048 * 2;
constexpr size_t OFF_BAR = al256(OFF_MOD + (size_t)2 * 3 * 6144 * 4);
constexpr size_t OFF_L = al256(OFF_BAR + (size_t)3456 * 4);
constexpr size_t OFF_H = OFF_L;
constexpr size_t OFF_CQN = OFF_H;
constexpr size_t OFF_CKVN = OFF_CQN + (size_t)NLAT * 768 * 2;
constexpr size_t OFF_Z = OFF_H + (size_t)NTOK * 2048 * 2;
constexpr size_t OFF_SG0 = OFF_Z + (size_t)NTOK * ZW * 2;
constexpr size_t OFF_QB = OFF_SG0 + (size_t)NLAT * 2048 * 2;
constexpr size_t OFF_KB = OFF_QB + (size_t)NLAT * 1024 * 2;
constexpr size_t OFF_VB = OFF_KB + (size_t)NB * 2 * LKV * 128 * 2;
constexpr size_t OFF_KPE = OFF_VB + (size_t)NB * 2 * LKV * 128 * 2;
constexpr size_t OFF_QA = OFF_KPE + (size_t)NB * LKV * 64 * 2;
constexpr size_t OFF_KA = OFF_QA + (size_t)NLAT * 1536 * 2;
constexpr size_t OFF_VA = OFF_KA + (size_t)NB * 8 * LKV * 128 * 2;
constexpr size_t END0 = OFF_VA + (size_t)NB * 8 * LKV * 128 * 2;
constexpr int NZS = 33024;
constexpr size_t OFF_ZS = OFF_L;
constexpr size_t OFF_H1 = OFF_ZS;
constexpr size_t OFF_PT = OFF_ZS + (size_t)NZS * 2048 * 2;
constexpr size_t OFF_XR = OFF_PT;
constexpr size_t OFF_XR128 = OFF_XR + (size_t)NLAT * 2048 * 2;
constexpr size_t OFF_SG = OFF_PT + (size_t)4096 * NLAT * 2;
constexpr size_t END1 = OFF_SG + (size_t)NLAT * 4096 * 2;
constexpr size_t WS_NEED = END0 > END1 ? END0 : END1;

struct Params {
    const float *x, *c, *ctx, *c_ctx, *ada_w, *ada_b, *ln_g, *ln_b, *w_in_attn, *wq_b, *q_lora_g, *kv_lora_g, *wkv_b, *qn_g, *kn_g, *w_out_attn, *w_in_f, *w_out_f;
    float* out; unsigned char* ws; int ph_lo, ph_hi;
};

__device__ __forceinline__ unsigned cvtpk(float lo, float hi) { unsigned r; asm("v_cvt_pk_bf16_f32 %0, %1, %2" : "=v"(r) : "v"(lo), "v"(hi)); return r; }
__device__ __forceinline__ int tid_l() { int t = threadIdx.x; asm volatile("" : "+v"(t)); return t; }
__device__ __forceinline__ int bid_l() { int t = blockIdx.x; asm volatile("" : "+s"(t)); return t; }
__device__ __forceinline__ float bflo(unsigned w) { return __uint_as_float(w << 16); }
__device__ __forceinline__ float bfhi(unsigned w) { return __uint_as_float(w & 0xffff0000u); }
__device__ __forceinline__ float bf2f(bf16_t b) { return __uint_as_float(((unsigned)b) << 16); }
__device__ __forceinline__ bf16_t f2bf(float f) { return (bf16_t)(cvtpk(f, 0.f) & 0xffffu); }
__device__ __forceinline__ float wave_sum(float v) {
#pragma unroll
    for (int o = 32; o > 0; o >>= 1) v += __shfl_xor(v, o);
    return v;
}
__device__ __forceinline__ float sum16(float v) {
#pragma unroll
    for (int o = 8; o > 0; o >>= 1) v += __shfl_xor(v, o);
    return v;
}
__device__ __forceinline__ float silu(float x) { return x / (1.f + __expf(-x)); }
__device__ __forceinline__ void unpack8(u32x4 w, float (&v)[8]) {
    v[0] = bflo(w.x); v[1] = bfhi(w.x); v[2] = bflo(w.y); v[3] = bfhi(w.y); v[4] = bflo(w.z); v[5] = bfhi(w.z); v[6] = bflo(w.w); v[7] = bfhi(w.w);
}
__device__ __forceinline__ u32x4 pack8(const float (&v)[8]) { u32x4 w; w.x = cvtpk(v[0], v[1]); w.y = cvtpk(v[2], v[3]); w.z = cvtpk(v[4], v[5]); w.w = cvtpk(v[6], v[7]); return w; }
__device__ __forceinline__ float cos_rev(float r) { return __builtin_amdgcn_cosf(r); }
__device__ __forceinline__ float sin_rev(float r) { return __builtin_amdgcn_sinf(r); }
__device__ __forceinline__ void rope8(float (&v)[8], int i0, int nhalf, float prow, float pcol) {
#pragma unroll
    for (int j = 0; j < 4; ++j) {
        const int i = i0 + j; const int fi = i < nhalf ? i : i - nhalf; const float pos = i < nhalf ? prow : pcol;
        const float inv = __builtin_amdgcn_exp2f(-(float)fi * (13.287712379549449f / (float)nhalf));
        const float rev = pos * inv * 0.15915494309189535f;
        const float cs = cos_rev(rev), sn = sin_rev(rev), a = v[2 * j], b = v[2 * j + 1];
        v[2 * j] = a * cs - b * sn; v[2 * j + 1] = a * sn + b * cs;
    }
}

namespace pg8 {
constexpr int BM = 256, BK = 64, HALF = 128, HTB = HALF * BK * 2, NXCD = 8, WGM = 8;
__device__ __forceinline__ int lds_byte(int r, int c) { const int st = (r >> 4) * 2 + (c >> 5), rr = r & 15, cc = c & 31, ob = rr * 64 + cc * 2; return st * 1024 + (ob ^ (((ob >> 9) & 1) << 5)); }
__device__ __forceinline__ void stage_rc(int b, int& R, int& C) { const int st = b / 1024, sb = b % 1024, swz = sb ^ (((sb >> 9) & 1) << 5); R = (st >> 1) * 16 + swz / 64; C = (st & 1) * 32 + (swz % 64) / 2; }
__device__ __forceinline__ int perm32(int rho) { const int n = rho >> 4, i = rho & 15; return 8 * (i >> 2) + 4 * n + (i & 3); }
struct Unit { int pm, pn; };
struct Gemm { const bf16_t* A; const bf16_t* Bt; int M, N, K, lda, ldb; };
struct StaticOrder {
    int nM, nN, nwg, G, c;
    __device__ void init(int M, int N, int G_, int c_) { nM = M / BM; nN = N / BM; nwg = nM * nN; G = G_; c = c_; }
    __device__ bool next(int i, Unit& u) const {
        const long L = (long)i * G + c; if (L >= nwg) return false;
        int wgid = (int)L; { const int q = nwg / NXCD, r = nwg % NXCD, xcd = wgid % NXCD, off = wgid / NXCD; wgid = (xcd < r ? xcd * (q + 1) : r * (q + 1) + (xcd - r) * q) + off; }
        const int nig = WGM * nN, gid = wgid / nig, fm = gid * WGM, gsz = (nM - fm) < WGM ? (nM - fm) : WGM;
        u.pm = fm + ((wgid % nig) % gsz); u.pn = (wgid % nig) / gsz; return true;
    }
};
struct OneUnit { int pm, pn; __device__ bool next(int i, Unit& u) const { if (i) return false; u.pm = pm; u.pn = pn; return true; } };

template <class Epi, class Sched>
__device__ __forceinline__ void gemm_phase(LAS unsigned char* lds, const Gemm g, const Sched& S, const Epi& E) {
    const int tid = tid_l(), wid = __builtin_amdgcn_readfirstlane(tid >> 6), lane = tid & 63, wr = wid >> 2, wc = wid & 3, fr = lane & 15, fq = lane >> 4;
    const int K = g.K, nt = K / BK;
    unsigned voffA[2], voffB[2];
#pragma unroll
    for (int i = 0; i < 2; ++i) { int R, C; stage_rc(tid * 16 + i * 8192, R, C); const int Rb = Epi::PERM ? ((R & ~31) + perm32(R & 31)) : R;
        voffA[i] = (unsigned)(R * g.lda + C) * 2u; voffB[i] = (unsigned)(Rb * g.ldb + C) * 2u; }
    const size_t kstep = (size_t)(BK * 2);
    const size_t hsA = (size_t)HALF * g.lda * 2, hsB = (size_t)HALF * g.ldb * 2;
    const size_t tsA = 2 * hsA, tsB = 2 * hsB;
    const unsigned ldsw = (unsigned)wid * 1024u;
    const int aoff = lds_byte(wr * 64 + fr, fq * 8), boff = lds_byte(wc * 32 + fr, fq * 8);
#define PG8_SA(b, h) (((b) * 2 + (h)) * HTB)
#define PG8_SB(b, h) ((4 + (b) * 2 + (h)) * HTB)
#define PG8_STAGE(bufoff, gbase, voff) do { _Pragma("unroll") for (int _i = 0; _i < 2; ++_i) \
        __builtin_amdgcn_global_load_lds((const unsigned*)((const char*)(gbase) + (voff)[_i]), (LAS unsigned*)(lds + (bufoff) + ldsw + _i * 8192), 16, 0, 0); } while (0)
#define PG8_LDA(dst, b, h) do { _Pragma("unroll") for (int m = 0; m < 4; ++m) _Pragma("unroll") for (int k = 0; k < 2; ++k) dst[m][k] = *(const LAS bf16x8*)(lds + PG8_SA(b, h) + aoff + m * 2048 + k * 1024); } while (0)
#define PG8_LDB(dst, b, h) do { _Pragma("unroll") for (int n = 0; n < 2; ++n) _Pragma("unroll") for (int k = 0; k < 2; ++k) dst[n][k] = *(const LAS bf16x8*)(lds + PG8_SB(b, h) + boff + n * 2048 + k * 1024); } while (0)
#define PG8_MMA(ai, bj, At, Bt) do { __builtin_amdgcn_s_setprio(1); _Pragma("unroll") for (int m = 0; m < 4; ++m) _Pragma("unroll") for (int n = 0; n < 2; ++n) _Pragma("unroll") for (int k = 0; k < 2; ++k) \
        acc[ai][bj][m][n] = __builtin_amdgcn_mfma_f32_16x16x32_bf16(Bt[n][k], At[m][k], acc[ai][bj][m][n], 0, 0, 0); __builtin_amdgcn_s_setprio(0); } while (0)
#define PG8_WAIT_V(n) asm volatile("s_waitcnt vmcnt(" #n ")" ::: "memory")
#define PG8_WAIT_L(n) asm volatile("s_waitcnt lgkmcnt(" #n ")" ::: "memory")
#define PG8_BAR __builtin_amdgcn_s_barrier()
#define PG8_SCHED __builtin_amdgcn_sched_barrier(0)
    Unit cur, nxt; int ui = 0;
    if (!S.next(0, cur)) return;
    f32x4 acc[2][2][4][2];
#pragma unroll
    for (int a = 0; a < 2; ++a)
#pragma unroll
        for (int b = 0; b < 2; ++b)
#pragma unroll
            for (int m = 0; m < 4; ++m)
#pragma unroll
                for (int n = 0; n < 2; ++n) acc[a][b][m][n] = (f32x4){0.f, 0.f, 0.f, 0.f};
    bf16x8 At[4][2], B0[2][2], B1[2][2];
    const char* cA = (const char*)g.A + (size_t)cur.pm * tsA; const char* cB = (const char*)g.Bt + (size_t)cur.pn * tsB;
    PG8_STAGE(PG8_SB(0, 0), cB, voffB); PG8_STAGE(PG8_SA(0, 0), cA, voffA); PG8_STAGE(PG8_SB(0, 1), cB + hsB, voffB); PG8_STAGE(PG8_SA(0, 1), cA + hsA, voffA);
    if (wr == 1) PG8_BAR;
    PG8_WAIT_V(4); PG8_BAR;
    PG8_STAGE(PG8_SB(1, 0), cB + kstep, voffB); PG8_STAGE(PG8_SA(1, 0), cA + kstep, voffA); PG8_STAGE(PG8_SB(1, 1), cB + hsB + kstep, voffB);
    PG8_WAIT_V(6); PG8_BAR;
    for (;;) {
        const bool has_next = S.next(ui + 1, nxt);
        const char* nA = has_next ? (const char*)g.A + (size_t)nxt.pm * tsA : cA; const char* nB = has_next ? (const char*)g.Bt + (size_t)nxt.pn * tsB : cB;
        for (int t = 0; t < nt; t += 2) {
            const bool last = (t == nt - 2);
            const char* a1 = cA + (size_t)(t + 1) * kstep;
            const char* a2 = last ? nA : cA + (size_t)(t + 2) * kstep; const char* b2 = last ? nB : cB + (size_t)(t + 2) * kstep;
            const char* a3 = a2 + kstep; const char* b3 = b2 + kstep;
            PG8_LDB(B0, 0, 0); PG8_SCHED; PG8_LDA(At, 0, 0); PG8_STAGE(PG8_SA(1, 1), a1 + hsA, voffA);
            PG8_WAIT_L(8); PG8_BAR; PG8_WAIT_L(0); PG8_MMA(0, 0, At, B0); PG8_BAR; PG8_SCHED;
            PG8_LDB(B1, 0, 1); PG8_STAGE(PG8_SB(0, 0), b2, voffB);
            PG8_BAR; PG8_WAIT_L(0); PG8_MMA(0, 1, At, B1); PG8_BAR;
            PG8_LDA(At, 0, 1); PG8_STAGE(PG8_SA(0, 0), a2, voffA);
            PG8_BAR; PG8_WAIT_L(0); PG8_MMA(1, 0, At, B0); PG8_BAR; PG8_SCHED;
            PG8_STAGE(PG8_SB(0, 1), b2 + hsB, voffB);
            PG8_WAIT_V(6); PG8_BAR; PG8_MMA(1, 1, At, B1); PG8_BAR;
            PG8_LDB(B0, 1, 0); PG8_SCHED; PG8_LDA(At, 1, 0); PG8_STAGE(PG8_SA(0, 1), a2 + hsA, voffA);
            PG8_WAIT_L(8); PG8_BAR; PG8_WAIT_L(0); PG8_MMA(0, 0, At, B0); PG8_BAR; PG8_SCHED;
            PG8_LDB(B1, 1, 1); PG8_STAGE(PG8_SB(1, 0), b3, voffB);
            PG8_BAR; PG8_WAIT_L(0); PG8_MMA(0, 1, At, B1); PG8_BAR;
            PG8_LDA(At, 1, 1); PG8_STAGE(PG8_SA(1, 0), a3, voffA);
            PG8_BAR; PG8_WAIT_L(0); PG8_MMA(1, 0, At, B0); PG8_BAR; PG8_SCHED;
            PG8_STAGE(PG8_SB(1, 1), b3 + hsB, voffB);
            PG8_WAIT_V(6); PG8_BAR; PG8_MMA(1, 1, At, B1); PG8_BAR;
        }
        E(acc, cur, wr, wc, fr, fq);
        if (!has_next) break;
#pragma unroll
        for (int a = 0; a < 2; ++a)
#pragma unroll
            for (int b = 0; b < 2; ++b)
#pragma unroll
                for (int m = 0; m < 4; ++m)
#pragma unroll
                    for (int n = 0; n < 2; ++n) acc[a][b][m][n] = (f32x4){0.f, 0.f, 0.f, 0.f};
        cur = nxt; cA = nA; cB = nB; ++ui;
    }
    PG8_WAIT_V(0);
    if (wr == 0) PG8_BAR;
    PG8_BAR;
#undef PG8_SA
#undef PG8_SB
#undef PG8_STAGE
#undef PG8_LDA
#undef PG8_LDB
#undef PG8_MMA
#undef PG8_WAIT_V
#undef PG8_WAIT_L
#undef PG8_BAR
#undef PG8_SCHED
}
template <class F> struct EpiB { static constexpr bool PERM = true; F f;
    __device__ __forceinline__ void operator()(const f32x4 (&acc)[2][2][4][2], const Unit& u, int wr, int wc, int fr, int fq) const {
#pragma unroll
        for (int ai = 0; ai < 2; ++ai)
#pragma unroll
            for (int m = 0; m < 4; ++m)
#pragma unroll
                for (int bj = 0; bj < 2; ++bj) {
                    const int row = u.pm * BM + ai * HALF + wr * 64 + m * 16 + fr, col = u.pn * BM + bj * HALF + wc * 32 + 8 * fq;
                    float v[8] = {acc[ai][bj][m][0][0], acc[ai][bj][m][0][1], acc[ai][bj][m][0][2], acc[ai][bj][m][0][3], acc[ai][bj][m][1][0], acc[ai][bj][m][1][1], acc[ai][bj][m][1][2], acc[ai][bj][m][1][3]};
                    f(row, col, v); }
    } };
template <class F> struct EpiF { static constexpr bool PERM = false; F f;
    __device__ __forceinline__ void operator()(const f32x4 (&acc)[2][2][4][2], const Unit& u, int wr, int wc, int fr, int fq) const {
#pragma unroll
        for (int ai = 0; ai < 2; ++ai)
#pragma unroll
            for (int m = 0; m < 4; ++m)
#pragma unroll
                for (int bj = 0; bj < 2; ++bj)
#pragma unroll
                    for (int n = 0; n < 2; ++n) {
                        const int row = u.pm * BM + ai * HALF + wr * 64 + m * 16 + fr, col = u.pn * BM + bj * HALF + wc * 32 + 16 * n + 4 * fq;
                        f(row, col, acc[ai][bj][m][n]); }
    } };
}

struct FStore { bf16_t* O; int ldc;
    __device__ __forceinline__ void operator()(int row, int col, float (&v)[8]) const { *(u32x4*)(O + (size_t)row * ldc + col) = pack8(v); } };
struct FSilu { bf16_t* O; int ldc;
    __device__ __forceinline__ void operator()(int row, int col, float (&v)[8]) const {
#pragma unroll
        for (int j = 0; j < 8; ++j) v[j] = silu(v[j]);
        *(u32x4*)(O + (size_t)row * ldc + col) = pack8(v); } };
struct FZ { bf16_t* Z; bf16_t* SG0;
    __device__ __forceinline__ void operator()(int row, int col, float (&v)[8]) const {
        if (col < ZW) { *(u32x4*)(Z + (size_t)row * ZW + col) = pack8(v); }
        else if (row < NLAT) {
#pragma unroll
            for (int j = 0; j < 8; ++j) v[j] = silu(v[j]);
            *(u32x4*)(SG0 + (size_t)row * 2048 + (col - ZW)) = pack8(v); } } };
struct FQa { bf16_t* Qa;
    __device__ __forceinline__ void operator()(int row, int col, float (&v)[8]) const {
        const int d = col % 192;
        if (d >= 128) { const int s = row & (SEQ - 1); rope8(v, (d - 128) >> 1, 16, (float)(s >> 6), (float)(s & 63)); }
        *(u32x4*)(Qa + (size_t)row * 1536 + col) = pack8(v); } };
struct FKva { bf16_t* Ka; bf16_t* Va;
    __device__ __forceinline__ void operator()(int row, int col, float (&v)[8]) const {
        const int head = col >> 8, dd = col & 255, d = dd & 127; int b, pos;
        if (row < NLAT) { b = row >> 13; pos = CTX + (row & (SEQ - 1)); } else { const int cr = row - NLAT; b = cr >> 8; pos = cr & 255; }
        bf16_t* dst = (dd >= 128 ? Va : Ka) + ((size_t)((b * 8 + head) * LKV + pos) * 128 + d);
        *(u32x4*)dst = pack8(v); } };
struct FRes { const float* xin; const float* gate; float* out;
    __device__ __forceinline__ void operator()(int row, int col, const f32x4& a) const {
        const int b = row >> 13; const size_t idx = (size_t)row * DM + col;
        const f32x4 xv = *(const f32x4*)(xin + idx), gv = *(const f32x4*)(gate + b * 6144 + col);
        *(f32x4*)(out + idx) = xv * ALPHA + gv * a; } };
struct FXr { bf16_t* XR; bf16_t* XR128;
    __device__ __forceinline__ void operator()(int row, int col, float (&v)[8]) const {
        if (col < 32768) { const int k2 = col & 127, s = (col >> 7) & 7, bg = col >> 10, b = bg >> 4, g = bg & 15;
            *(u32x4*)(XR + (size_t)(b * SEQ + 8 * row + s) * 2048 + g * 128 + k2) = pack8(v); }
        else { const int bg = (col - 32768) >> 3, b = bg >> 4, g = bg & 15;
#pragma unroll
            for (int s = 0; s < 8; ++s) XR128[(size_t)(b * SEQ + 8 * row + s) * 16 + g] = f2bf(v[s]); } } };

#define KSWZ(row, colB) ((row) * 256 + ((colB) ^ (((row) & 7) << 4)))
#define XSWZ(row, colB) ((row) * 128 + ((colB) ^ (((row) & 7) << 4)))
#define SBAR() __builtin_amdgcn_sched_barrier(0)
constexpr int A_SHM_V = 64 * 128 * 2, A_SHM_K = 64 * 128 * 2, A_SHM_X = 64 * 64 * 2;
__device__ __forceinline__ unsigned cvtpk_v(float lo, float hi) { unsigned r; asm volatile("v_cvt_pk_bf16_f32 %0, %1, %2" : "=v"(r) : "v"(lo), "v"(hi)); return r; }
__device__ __forceinline__ int crow(int r, int hi) { return (r & 3) + 8 * (r >> 2) + 4 * hi; }
__device__ __forceinline__ void partialSM(f32x16& p0, f32x16& p1, float& m_reg, float& mn, float& alpha, const float SCALE) {
    const float C = SCALE * 1.4426950408889634f; const float THRS = 8.f / SCALE;
    float pmax = p0[0];
#pragma unroll
    for (int r = 1; r < 16; ++r) pmax = fmaxf(pmax, p0[r]);
#pragma unroll
    for (int r = 0; r < 16; ++r) pmax = fmaxf(pmax, p1[r]);
    { auto rr = __builtin_amdgcn_permlane32_swap(__float_as_uint(pmax), __float_as_uint(pmax), false, false);
      pmax = fmaxf(__uint_as_float(rr[0]), __uint_as_float(rr[1])); }
    if (__builtin_expect(__all(pmax - m_reg <= THRS), 1)) { mn = m_reg; alpha = 1.f; }
    else { mn = fmaxf(m_reg, pmax); alpha = __builtin_amdgcn_exp2f((m_reg - mn) * C); m_reg = mn; }
    const float mnC = -mn * C;
#pragma unroll
    for (int r = 0; r < 16; ++r) p0[r] = fmaf(p0[r], C, mnC);
#pragma unroll
    for (int r = 0; r < 16; ++r) p1[r] = fmaf(p1[r], C, mnC);
#pragma unroll
    for (int r = 0; r < 16; ++r) p0[r] = __builtin_amdgcn_exp2f(p0[r]);
}
__device__ __forceinline__ void finishSM(f32x16& p0, f32x16& p1, float alpha, float& l_reg, bf16x8& pa0, bf16x8& pa1, bf16x8& pa2, bf16x8& pa3) {
#pragma unroll
    for (int r = 0; r < 16; ++r) p1[r] = __builtin_amdgcn_exp2f(p1[r]);
    float ps = 0;
#pragma unroll
    for (int r = 0; r < 16; ++r) ps += p0[r];
#pragma unroll
    for (int r = 0; r < 16; ++r) ps += p1[r];
    { auto rr = __builtin_amdgcn_permlane32_swap(__float_as_uint(ps), __float_as_uint(ps), false, false);
      ps = __uint_as_float(rr[0]) + __uint_as_float(rr[1]); }
    l_reg = l_reg * alpha + ps;
#define PK4(P, BASE, OUT) do { unsigned a0 = cvtpk_v(P[BASE + 0], P[BASE + 1]), a1 = cvtpk_v(P[BASE + 2], P[BASE + 3]);   \
    unsigned b0 = cvtpk_v(P[BASE + 4], P[BASE + 5]), b1 = cvtpk_v(P[BASE + 6], P[BASE + 7]);                              \
    auto r0 = __builtin_amdgcn_permlane32_swap(a0, b0, false, false); auto r1 = __builtin_amdgcn_permlane32_swap(a1, b1, false, false); \
    u32x4 w = {r0[0], r1[0], r0[1], r1[1]}; OUT = *reinterpret_cast<bf16x8*>(&w); } while (0)
    PK4(p0, 0, pa0); PK4(p0, 8, pa1); PK4(p1, 0, pa2); PK4(p1, 8, pa3);
#undef PK4
}
template <int XD>
__device__ __forceinline__ void qkt(f32x16& p0, f32x16& p1, const char* Ks, const char* Xs, const bf16x8* qr, const bf16x8* qx, int r32, int hi) {
    p0 = f32x16{}; p1 = f32x16{};
#pragma unroll
    for (int d0 = 0; d0 < 8; ++d0) { const int cb = (d0 * 16 + hi * 8) * 2;
        bf16x8 b0 = *reinterpret_cast<const bf16x8*>(Ks + KSWZ(r32, cb));
        bf16x8 b1 = *reinterpret_cast<const bf16x8*>(Ks + KSWZ(32 + r32, cb));
        p0 = __builtin_amdgcn_mfma_f32_32x32x16_bf16(b0, qr[d0], p0, 0, 0, 0);
        p1 = __builtin_amdgcn_mfma_f32_32x32x16_bf16(b1, qr[d0], p1, 0, 0, 0); }
    if constexpr (XD > 0) {
#pragma unroll
        for (int d0 = 0; d0 < XD / 16; ++d0) { const int cb = (d0 * 16 + hi * 8) * 2;
            bf16x8 b0 = *reinterpret_cast<const bf16x8*>(Xs + XSWZ(r32, cb));
            bf16x8 b1 = *reinterpret_cast<const bf16x8*>(Xs + XSWZ(32 + r32, cb));
            p0 = __builtin_amdgcn_mfma_f32_32x32x16_bf16(b0, qx[d0], p0, 0, 0, 0);
            p1 = __builtin_amdgcn_mfma_f32_32x32x16_bf16(b1, qx[d0], p1, 0, 0, 0); }
    }
}
__device__ __forceinline__ int v_st(int k, int c) { const int kk = (k & ~0xC) | ((k & 4) << 1) | ((k & 8) >> 1); return ((kk >> 3) * 4 + (c >> 5)) * 512 + ((kk & 7) * 32 + (c & 31)) * 2; }
__device__ __forceinline__ int v_rd_base(int lane) { return ((lane & 3) << 3) | (((lane >> 2) & 3) << 6) | (((lane >> 4) & 1) << 5) | (((lane >> 5) & 1) << 8); }
constexpr int v_rd_off(int d0, int ks, int half) { return d0 * 512 + ks * 4096 + half * 2048; }
template <int OFF> __device__ __forceinline__ s16x4 tr_read(int vb) {
    s16x4 r; asm volatile("ds_read_b64_tr_b16 %0, %1 offset:%2" : "=&v"(r) : "v"(vb), "i"(OFF) : "memory"); return r;
}
template <int D0> __device__ __forceinline__ void pv_one(f32x16& od, int vb, bf16x8 pa0, bf16x8 pa1, bf16x8 pa2, bf16x8 pa3) {
    const s16x4 l0 = tr_read<v_rd_off(D0, 0, 0)>(vb), h0 = tr_read<v_rd_off(D0, 0, 1)>(vb), l1 = tr_read<v_rd_off(D0, 1, 0)>(vb), h1 = tr_read<v_rd_off(D0, 1, 1)>(vb);
    const s16x4 l2 = tr_read<v_rd_off(D0, 2, 0)>(vb), h2 = tr_read<v_rd_off(D0, 2, 1)>(vb), l3 = tr_read<v_rd_off(D0, 3, 0)>(vb), h3 = tr_read<v_rd_off(D0, 3, 1)>(vb);
    asm volatile("s_waitcnt lgkmcnt(0)" ::: "memory"); SBAR();
#define PK(L, H) (bf16x8){L[0], L[1], L[2], L[3], H[0], H[1], H[2], H[3]}
    od = __builtin_amdgcn_mfma_f32_32x32x16_bf16(pa0, PK(l0, h0), od, 0, 0, 0);
    od = __builtin_amdgcn_mfma_f32_32x32x16_bf16(pa1, PK(l1, h1), od, 0, 0, 0);
    od = __builtin_amdgcn_mfma_f32_32x32x16_bf16(pa2, PK(l2, h2), od, 0, 0, 0);
    od = __builtin_amdgcn_mfma_f32_32x32x16_bf16(pa3, PK(l3, h3), od, 0, 0, 0);
#undef PK
}
__device__ __forceinline__ void pv_d0(f32x16* o, int vb, bf16x8 pa0, bf16x8 pa1, bf16x8 pa2, bf16x8 pa3) {
    pv_one<0>(o[0], vb, pa0, pa1, pa2, pa3); pv_one<1>(o[1], vb, pa0, pa1, pa2, pa3); pv_one<2>(o[2], vb, pa0, pa1, pa2, pa3); pv_one<3>(o[3], vb, pa0, pa1, pa2, pa3);
}
template <int XD, int SDEPTH, int LDQ>
__device__ __forceinline__ void attn_body(const bf16_t* __restrict__ Qb, const bf16_t* __restrict__ Kh, const bf16_t* __restrict__ Vh, const bf16_t* __restrict__ Kx,
                                          bf16_t* __restrict__ Yb, int seq, char* lds, const float SCALE, const bool dry) {
    const int tid = tid_l(), wid = tid >> 6, lane = tid & 63, r32 = lane & 31, hi = lane >> 5;
    char* V_lds = lds; char* K_lds = lds + 2 * A_SHM_V; char* X_lds = lds + 2 * A_SHM_V + 2 * A_SHM_K;
    float* wsf = (float*)(lds + 2 * A_SHM_V + 2 * A_SHM_K + 2 * A_SHM_X) + wid * 64; float* li_l = wsf; float* al_l = wsf + 32;
    float m_reg = -1e30f, l_reg = 0; f32x16 o[4] = {}; bf16x8 qr[8]; bf16x8 qx[XD > 0 ? XD / 16 : 1];
    const bf16_t* Qw = Qb + (long)(wid * 32 + r32) * LDQ + hi * 8;
#pragma unroll
    for (int d0 = 0; d0 < 8; ++d0) qr[d0] = *reinterpret_cast<const bf16x8*>(Qw + d0 * 16);
    if constexpr (XD > 0) {
#pragma unroll
        for (int d0 = 0; d0 < XD / 16; ++d0) qx[d0] = *reinterpret_cast<const bf16x8*>(Qw + 128 + d0 * 16);
    }
    const int sr = tid >> 4, sc = (tid & 15) * 8, vst0 = v_st(sr, sc), vst1 = v_st(32 + sr, sc);
    const int xr = tid >> 3, xc = (tid & 7) * 8;
    const int vb0 = (int)(uintptr_t)V_lds + v_rd_base(lane);
    struct { bf16x8 vs0, vs1, ks0, ks1, xs; } sr_[SDEPTH];
#define SLOAD(i, k0) do { sr_[i].vs0 = *(const bf16x8*)(&Vh[(long)((k0) + sr) * 128 + sc]); sr_[i].vs1 = *(const bf16x8*)(&Vh[(long)((k0) + 32 + sr) * 128 + sc]); \
    sr_[i].ks0 = *(const bf16x8*)(&Kh[(long)((k0) + sr) * 128 + sc]); sr_[i].ks1 = *(const bf16x8*)(&Kh[(long)((k0) + 32 + sr) * 128 + sc]); \
    if constexpr (XD > 0) sr_[i].xs = *(const bf16x8*)(&Kx[(long)((k0) + xr) * 64 + xc]); } while (0)
#define SWRITE(b, i) do { *(bf16x8*)(V_lds + (b) * A_SHM_V + vst0) = sr_[i].vs0;          \
    *(bf16x8*)(V_lds + (b) * A_SHM_V + vst1) = sr_[i].vs1; int kc = sc * 2;               \
    *(bf16x8*)(K_lds + (b) * A_SHM_K + KSWZ(sr, kc)) = sr_[i].ks0;                       \
    *(bf16x8*)(K_lds + (b) * A_SHM_K + KSWZ(32 + sr, kc)) = sr_[i].ks1;                  \
    if constexpr (XD > 0) *(bf16x8*)(X_lds + (b) * A_SHM_X + XSWZ(xr, xc * 2)) = sr_[i].xs; } while (0)
#define SWAIT() do { if constexpr (SDEPTH == 2) { if constexpr (XD > 0) asm volatile("s_waitcnt vmcnt(5)" ::: "memory"); else asm volatile("s_waitcnt vmcnt(4)" ::: "memory"); } \
    else asm volatile("s_waitcnt vmcnt(0)" ::: "memory"); } while (0)
#define RESC(a) do { if (__any((a) < 1.f)) { if (hi == 0) al_l[r32] = (a); asm volatile("s_waitcnt lgkmcnt(0)" ::: "memory"); \
    _Pragma("unroll") for (int d = 0; d < 4; ++d) _Pragma("unroll") for (int r = 0; r < 16; ++r) o[d][r] *= al_l[crow(r, hi)]; } } while (0)
    f32x16 pA0, pA1, pB0, pB1; float mnA, mnB, alA, alB; bf16x8 pa0, pa1, pa2, pa3; const int NT = seq / 64;
    constexpr int SE = 0, SO = SDEPTH - 1;
    SLOAD(SE, 0); asm volatile("s_waitcnt vmcnt(0)" ::: "memory"); SWRITE(0, SE); __syncthreads();
    qkt<XD>(pA0, pA1, K_lds, X_lds, qr, qx, r32, hi); partialSM(pA0, pA1, m_reg, mnA, alA, SCALE);
    SLOAD(SO, 64); if constexpr (SDEPTH == 2) { if (2 < NT) SLOAD(SE, 2 * 64); }
    SWAIT(); SWRITE(1, SO); __syncthreads();
    for (int j = 1; j + 1 < NT; j += 2) {
        SBAR(); qkt<XD>(pB0, pB1, K_lds + A_SHM_K, X_lds + A_SHM_X, qr, qx, r32, hi);
        finishSM(pA0, pA1, alA, l_reg, pa0, pa1, pa2, pa3); SBAR();
        SLOAD(SO, (j + SDEPTH) * 64); SBAR();
        pv_d0(o, vb0, pa0, pa1, pa2, pa3); partialSM(pB0, pB1, m_reg, mnB, alB, SCALE);
        __syncthreads(); SWAIT(); SWRITE(0, SE);
        RESC(alB); __syncthreads();
        SBAR(); qkt<XD>(pA0, pA1, K_lds, X_lds, qr, qx, r32, hi);
        finishSM(pB0, pB1, alB, l_reg, pa0, pa1, pa2, pa3); SBAR();
        if (SDEPTH == 1 || j + 3 < NT) SLOAD(SE, (j + 1 + SDEPTH) * 64); SBAR();
        pv_d0(o, vb0 + A_SHM_V, pa0, pa1, pa2, pa3); partialSM(pA0, pA1, m_reg, mnA, alA, SCALE);
        __syncthreads(); SWAIT(); SWRITE(1, SO);
        RESC(alA); __syncthreads();
    }
    SBAR(); qkt<XD>(pB0, pB1, K_lds + A_SHM_K, X_lds + A_SHM_X, qr, qx, r32, hi);
    finishSM(pA0, pA1, alA, l_reg, pa0, pa1, pa2, pa3); SBAR();
    pv_d0(o, vb0, pa0, pa1, pa2, pa3); partialSM(pB0, pB1, m_reg, mnB, alB, SCALE);
    __syncthreads(); RESC(alB);
    finishSM(pB0, pB1, alB, l_reg, pa0, pa1, pa2, pa3); SBAR();
    pv_d0(o, vb0 + A_SHM_V, pa0, pa1, pa2, pa3);
    if (hi == 0) li_l[r32] = l_reg; asm volatile("s_waitcnt lgkmcnt(0)" ::: "memory");
    float rli[16];
#pragma unroll
    for (int r = 0; r < 16; ++r) rli[r] = __builtin_amdgcn_rcpf(li_l[crow(r, hi)]);
    bf16_t* Yw = Yb + (long)(wid * 32) * 2048;
    if (!dry)
#pragma unroll
    for (int r = 0; r < 16; ++r) { const int orow = crow(r, hi);
#pragma unroll
        for (int d0 = 0; d0 < 4; ++d0) { bf16_t* yp = Yw + (long)orow * 2048 + d0 * 32 + r32; *yp = f2bf(o[d0][r] * rli[r] * bf2f(*yp)); } }
    __syncthreads();
#undef SLOAD
#undef SWRITE
#undef SWAIT
#undef RESC
}

__device__ __forceinline__ void tconv_tile(const float* src, int ld, int k0, int sc0, bf16_t* dst, int ldd, int n0, float* tile) {
    const int tid = tid_l();
#pragma unroll
    for (int i = 0; i < 2; ++i) { const int r = (tid >> 4) + 32 * i, c = (tid & 15) * 4;
        f32x4 v = {0.f, 0.f, 0.f, 0.f}; if (sc0 >= 0) v = *(const f32x4*)(src + (size_t)(k0 + r) * ld + sc0 + c);
        tile[r * 65 + c] = v[0]; tile[r * 65 + c + 1] = v[1]; tile[r * 65 + c + 2] = v[2]; tile[r * 65 + c + 3] = v[3]; }
    __syncthreads();
    { const int n = tid >> 3, k8 = (tid & 7) * 8; float v[8];
#pragma unroll
      for (int j = 0; j < 8; ++j) v[j] = tile[(k8 + j) * 65 + n];
      *(u32x4*)(dst + (size_t)(n0 + n) * ldd + k0 + k8) = pack8(v); }
    __syncthreads();
}
__device__ __forceinline__ int wi_src(int n0) {
    if (n0 < 1280) return n0;
    if (n0 < 2304) return 1344 + (n0 - 1280);
    if (n0 < 2560) return 2368 + (n0 - 2304);
    if (n0 < 2816) return 2624 + (n0 - 2560);
    if (n0 < 2880) return 1280 + (n0 - 2816);
    if (n0 < 3072) return -1;
    return 2880 + (n0 - 3072);
}

__device__ __forceinline__ void phase_prep(const Params& p, float* ldsf) {
    const int tid = tid_l(), G = gridDim.x, bid = blockIdx.x, lane = tid & 63, wid = tid >> 6;
    unsigned char* ws = p.ws;
    if (bid == 0) { unsigned* bw = (unsigned*)(ws + OFF_BAR); for (int i = tid; i < 3456; i += 512) bw[i] = 0u; }
    float* sv = ldsf; float* red = ldsf + 3 * 2048;
    for (int i = tid; i < 3 * 2048; i += 512) { const int vec = i >> 11, k = i & 2047; const float v = vec < 2 ? p.c[vec * 2048 + k] : p.c_ctx[k]; sv[i] = silu(v); }
    __syncthreads();
    float* mod = (float*)(ws + OFF_MOD);
    for (int unit = bid; unit < 384; unit += G) {
        const int layer = unit / 192, col0 = (unit % 192) * 32, kc = tid >> 3, c4 = (tid & 7) * 4;
        const float* W = p.ada_w + (size_t)layer * 2048 * 6144 + col0 + c4;
        f32x4 a0 = {0, 0, 0, 0}, a1 = a0, a2 = a0;
#pragma unroll 4
        for (int i = 0; i < 32; ++i) { const int k = kc + 64 * i; const f32x4 w = *(const f32x4*)(W + (size_t)k * 6144);
            a0 += w * sv[k]; a1 += w * sv[2048 + k]; a2 += w * sv[4096 + k]; }
#pragma unroll
        for (int j = 0; j < 4; ++j) {
#pragma unroll
            for (int o = 8; o < 64; o <<= 1) { a0[j] += __shfl_xor(a0[j], o); a1[j] += __shfl_xor(a1[j], o); a2[j] += __shfl_xor(a2[j], o); } }
        if (lane < 8) {
#pragma unroll
            for (int j = 0; j < 4; ++j) { red[(wid * 3 + 0) * 32 + c4 + j] = a0[j]; red[(wid * 3 + 1) * 32 + c4 + j] = a1[j]; red[(wid * 3 + 2) * 32 + c4 + j] = a2[j]; } }
        __syncthreads();
        if (tid < 96) { const int vec = tid >> 5, cc = tid & 31; float s = 0;
#pragma unroll
            for (int w = 0; w < 8; ++w) s += red[(w * 3 + vec) * 32 + cc];
            mod[(layer * 3 + vec) * 6144 + col0 + cc] = s + p.ada_b[layer * 6144 + col0 + cc]; }
        __syncthreads();
    }
    __syncthreads();
    float* tile = ldsf;
    for (int T = bid; T < 8224; T += G) {
        int t = T;
        if (t < 2560) { const int kt = t & 31, nt = t >> 5; tconv_tile(p.w_in_attn, 4928, kt * 64, wi_src(nt * 64), (bf16_t*)(ws + OFF_WI), 2048, nt * 64, tile); continue; }
        t -= 2560;
        if (t < 288) { const int kt = t % 12, nt = t / 12; tconv_tile(p.wq_b, 1536, kt * 64, nt * 64, (bf16_t*)(ws + OFF_WQ), 768, nt * 64, tile); continue; }
        t -= 288;
        if (t < 256) { const int kt = t & 7, nt = t >> 3; tconv_tile(p.wkv_b, 2048, kt * 64, nt * 64, (bf16_t*)(ws + OFF_WKV), 512, nt * 64, tile); continue; }
        t -= 256;
        if (t < 1024) { const int kt = t & 31, nt = t >> 5; tconv_tile(p.w_out_attn, 2048, kt * 64, nt * 64, (bf16_t*)(ws + OFF_WO), 2048, nt * 64, tile); continue; }
        t -= 1024;
        if (t < 2048) { const int kt = t & 31, nt = t >> 5; tconv_tile(p.w_in_f, 8192, kt * 64, 4096 + nt * 64, (bf16_t*)(ws + OFF_WFG), 2048, nt * 64, tile); continue; }
        t -= 2048;
        { const int kt = t & 63, nt = t >> 6; tconv_tile(p.w_out_f, 2048, kt * 64, nt * 64, (bf16_t*)(ws + OFF_WOF), 4096, nt * 64, tile); }
    }
    { bf16_t* Wub = (bf16_t*)(ws + OFF_WUB);
      for (int i = bid * 512 + tid; i < 2048 * 512; i += G * 512) { const int k = i >> 9, c8 = (i & 511) * 8;
          const f32x4 a = *(const f32x4*)(p.w_in_f + (size_t)k * 8192 + c8), b = *(const f32x4*)(p.w_in_f + (size_t)k * 8192 + c8 + 4);
          float v[8] = {a[0], a[1], a[2], a[3], b[0], b[1], b[2], b[3]}; *(u32x4*)(Wub + (size_t)k * 4096 + c8) = pack8(v); } }
    { bf16_t* Tt = (bf16_t*)(ws + OFF_TT);
      for (int i = bid * 512 + tid; i < 65536; i += G * 512) { const int j = i >> 8, n2 = i & 255; const int jj = j <= 128 ? j : j - 128;
          const float rev = (float)((jj * n2) & 255) * (1.f / 256.f); const float v = (j <= 128 ? cos_rev(rev) : sin_rev(rev)) * 0.0625f; Tt[i] = f2bf(v); } }
    { bf16_t* Tr = (bf16_t*)(ws + OFF_TRIG);
      for (int i = bid * 512 + tid; i < 1024 * 2048; i += G * 512) { const int m = i >> 11, n = i & 2047, np = n & 1023;
          const float rev = (float)((m * np) & 1023) * (1.f / 1024.f); Tr[i] = f2bf(n < 1024 ? cos_rev(rev) : sin_rev(rev)); } }
}

__device__ __forceinline__ void row_stats(const f32x4 (&v)[8], float& mean, float& rstd) {
    float s = 0;
#pragma unroll
    for (int i = 0; i < 8; ++i) s += v[i][0] + v[i][1] + v[i][2] + v[i][3];
    mean = wave_sum(s) * (1.f / 2048.f);
    float q = 0;
#pragma unroll
    for (int i = 0; i < 8; ++i) { const f32x4 d = v[i] - mean; q += d[0] * d[0] + d[1] * d[1] + d[2] * d[2] + d[3] * d[3]; }
    rstd = rsqrtf(wave_sum(q) * (1.f / 2048.f) + 1e-6f);
}
__device__ __forceinline__ void mod_store(const f32x4 (&v)[8], float mean, float rstd, const float* shift, const float* scale, bf16_t* hr, int lane) {
#pragma unroll
    for (int i = 0; i < 8; ++i) { const int c = i * 256 + lane * 4; const f32x4 sc = *(const f32x4*)(scale + c), sh = *(const f32x4*)(shift + c);
        const f32x4 y = (v[i] - mean) * rstd * (sc + 1.f) + sh; u32x2 w; w.x = cvtpk(y[0], y[1]); w.y = cvtpk(y[2], y[3]); *(u32x2*)(hr + c) = w; }
}

__device__ __forceinline__ void phase_ln0(const Params& p) {
    const int tid = tid_l(), lane = tid & 63, wid = tid >> 6, G = gridDim.x;
    const float* mod = (const float*)(p.ws + OFF_MOD); bf16_t* H = (bf16_t*)(p.ws + OFF_H);
    for (int r = blockIdx.x * 8 + wid; r < NTOK; r += G * 8) {
        const float* xr; int vec;
        if (r < NLAT) { xr = p.x + (size_t)r * DM; vec = r >> 13; } else { xr = p.ctx + (size_t)(r - NLAT) * DM; vec = 2; }
        f32x4 v[8];
#pragma unroll
        for (int i = 0; i < 8; ++i) v[i] = *(const f32x4*)(xr + i * 256 + lane * 4);
        float mean, rstd; row_stats(v, mean, rstd);
        mod_store(v, mean, rstd, mod + vec * 6144, mod + vec * 6144 + 2048, H + (size_t)r * DM, lane);
    }
}
__device__ __forceinline__ void phase_fold(const Params& p, LAS unsigned char* lds) {
    for (int w = blockIdx.x; w < 128; w += gridDim.x) {
        const int g = w >> 3;
        pg8::Gemm gm{(const bf16_t*)(p.ws + OFF_TT), (const bf16_t*)(p.ws + OFF_WUB) + g * 256, 256, 2048, 256, 256, 4096};
        pg8::OneUnit S{0, w & 7};
        pg8::EpiB<FStore> E{FStore{(bf16_t*)(p.ws + OFF_WFU) + (size_t)g * 256 * 2048, 2048}};
        pg8::gemm_phase(lds, gm, S, E);
    }
}

__device__ __forceinline__ void phase_postz(const Params& p) {
    const int tid = tid_l(), lane = tid & 63, wid = tid >> 6, G = gridDim.x;
    unsigned char* ws = p.ws;
    const bf16_t* Z = (const bf16_t*)(ws + OFF_Z);
    bf16_t* CQN = (bf16_t*)(ws + OFF_CQN); bf16_t* CKVN = (bf16_t*)(ws + OFF_CKVN); bf16_t* QB = (bf16_t*)(ws + OFF_QB);
    bf16_t* KB = (bf16_t*)(ws + OFF_KB); bf16_t* VB = (bf16_t*)(ws + OFF_VB); bf16_t* KPE = (bf16_t*)(ws + OFF_KPE);
    for (int r = blockIdx.x * 8 + wid; r < NTOK; r += G * 8) {
        const bf16_t* zr = Z + (size_t)r * ZW; const bool lat = r < NLAT; int b, pos, s;
        if (lat) { b = r >> 13; s = r & (SEQ - 1); pos = CTX + s; } else { const int cr = r - NLAT; b = cr >> 8; pos = cr & 255; s = 0; }
        const float prow = (float)(s >> 6), pcol = (float)(s & 63);
        float v[8];
        if (lat) {
            float v2[8]; unpack8(*(const u32x4*)(zr + lane * 8), v); float ss = 0;
#pragma unroll
            for (int j = 0; j < 8; ++j) ss += v[j] * v[j];
            if (lane < 32) { unpack8(*(const u32x4*)(zr + 512 + lane * 8), v2);
#pragma unroll
                for (int j = 0; j < 8; ++j) ss += v2[j] * v2[j]; }
            const float rstd = rsqrtf(wave_sum(ss) * (1.f / 768.f) + 1e-6f);
#pragma unroll
            for (int j = 0; j < 8; ++j) v[j] = v[j] * rstd * p.q_lora_g[lane * 8 + j];
            *(u32x4*)(CQN + (size_t)r * 768 + lane * 8) = pack8(v);
            if (lane < 32) {
#pragma unroll
                for (int j = 0; j < 8; ++j) v2[j] = v2[j] * rstd * p.q_lora_g[512 + lane * 8 + j];
                *(u32x4*)(CQN + (size_t)r * 768 + 512 + lane * 8) = pack8(v2); }
        }
        {
            unpack8(*(const u32x4*)(zr + 768 + lane * 8), v); float ss = 0;
#pragma unroll
            for (int j = 0; j < 8; ++j) ss += v[j] * v[j];
            const float rstd = rsqrtf(wave_sum(ss) * (1.f / 512.f) + 1e-6f);
#pragma unroll
            for (int j = 0; j < 8; ++j) v[j] = v[j] * rstd * p.kv_lora_g[lane * 8 + j];
            *(u32x4*)(CKVN + (size_t)r * 512 + lane * 8) = pack8(v);
        }
        const int d = (lane & 15) * 8;
        if (lat) {
#pragma unroll
            for (int ps = 0; ps < 2; ++ps) {
                unpack8(*(const u32x4*)(zr + 1280 + ps * 512 + lane * 8), v); float ss = 0;
#pragma unroll
                for (int j = 0; j < 8; ++j) ss += v[j] * v[j];
                const float rstd = rsqrtf(sum16(ss) * (1.f / 128.f) + 1e-6f);
#pragma unroll
                for (int j = 0; j < 8; ++j) v[j] = v[j] * rstd * p.qn_g[d + j];
                rope8(v, d >> 1, 32, prow, pcol);
                *(u32x4*)(QB + (size_t)r * 1024 + ps * 512 + lane * 8) = pack8(v);
            }
        }
        {
            unpack8(*(const u32x4*)(zr + 2304 + lane * 8), v); float ss = 0;
#pragma unroll
            for (int j = 0; j < 8; ++j) ss += v[j] * v[j];
            const float rstd = rsqrtf(sum16(ss) * (1.f / 128.f) + 1e-6f);
            const int head = (lane >> 4) & 1; const bool isV = lane >= 32;
            if (!isV) {
#pragma unroll
                for (int j = 0; j < 8; ++j) v[j] = v[j] * rstd * p.kn_g[d + j];
                if (lat) rope8(v, d >> 1, 32, prow, pcol);
            }
            bf16_t* dst = (isV ? VB : KB) + ((size_t)((b * 2 + head) * LKV + pos) * 128 + d);
            *(u32x4*)dst = pack8(v);
        }
        if (lane < 8) {
            unpack8(*(const u32x4*)(zr + 2816 + lane * 8), v);
            if (lat) rope8(v, lane * 4, 16, prow, pcol);
            *(u32x4*)(KPE + (size_t)(b * LKV + pos) * 64 + lane * 8) = pack8(v);
        }
    }
}

__device__ __forceinline__ void phase_ln1(const Params& p) {
    const int tid = tid_l(), lane = tid & 63, wid = tid >> 6, G = gridDim.x;
    const float* mod1 = (const float*)(p.ws + OFF_MOD) + 3 * 6144; bf16_t* H1 = (bf16_t*)(p.ws + OFF_H1);
    for (int r = blockIdx.x * 8 + wid; r < NLAT; r += G * 8) {
        float* xr = p.out + (size_t)r * DM; const int vec = r >> 13;
        f32x4 v[8];
#pragma unroll
        for (int i = 0; i < 8; ++i) v[i] = *(const f32x4*)(xr + i * 256 + lane * 4);
        float mean, rstd; row_stats(v, mean, rstd);
#pragma unroll
        for (int i = 0; i < 8; ++i) { const int c = i * 256 + lane * 4; const f32x4 g = *(const f32x4*)(p.ln_g + c), bb = *(const f32x4*)(p.ln_b + c);
            v[i] = (v[i] - mean) * rstd * g + bb; *(f32x4*)(xr + c) = v[i]; }
        row_stats(v, mean, rstd);
        mod_store(v, mean, rstd, mod1 + vec * 6144, mod1 + vec * 6144 + 2048, H1 + (size_t)r * DM, lane);
    }
}
__device__ __forceinline__ void phase_ln2(const Params& p) {
    const int tid = tid_l(), lane = tid & 63, wid = tid >> 6, G = gridDim.x;
    for (int r = blockIdx.x * 8 + wid; r < NLAT; r += G * 8) {
        float* xr = p.out + (size_t)r * DM;
        f32x4 v[8];
#pragma unroll
        for (int i = 0; i < 8; ++i) v[i] = *(const f32x4*)(xr + i * 256 + lane * 4);
        float mean, rstd; row_stats(v, mean, rstd);
#pragma unroll
        for (int i = 0; i < 8; ++i) { const int c = i * 256 + lane * 4; const f32x4 g = *(const f32x4*)(p.ln_g + DM + c), bb = *(const f32x4*)(p.ln_b + DM + c);
            *(f32x4*)(xr + c) = (v[i] - mean) * rstd * g + bb; }
    }
}

__device__ __forceinline__ void phase_radix8(const Params& p) {
    const int tid = tid_l(), G = gridDim.x;
    const bf16_t* PT = (const bf16_t*)(p.ws + OFF_PT); bf16_t* ZS = (bf16_t*)(p.ws + OFF_ZS);
    for (int u = blockIdx.x; u < 4128; u += G) {
        int bg, k2; if (u < 4096) { bg = u >> 7; k2 = u & 127; } else { bg = u - 4096; k2 = 128; }
        const int b = bg >> 4, g = bg & 15;
        const bf16_t* Pp = PT + (size_t)(g * 256 + k2) * NLAT + b * SEQ + 2 * tid;
        const bool hasQ = (k2 >= 1 && k2 <= 127);
        const bf16_t* Qp = PT + (size_t)(g * 256 + 128 + k2) * NLAT + b * SEQ + 2 * tid;
        float zr[8][2], zi[8][2];
#pragma unroll
        for (int q = 0; q < 8; ++q) { const unsigned w = *(const unsigned*)(Pp + 1024 * q); zr[q][0] = bflo(w); zr[q][1] = bfhi(w);
            if (hasQ) { const unsigned w2 = *(const unsigned*)(Qp + 1024 * q); zi[q][0] = -bflo(w2); zi[q][1] = -bfhi(w2); } else { zi[q][0] = 0.f; zi[q][1] = 0.f; } }
        constexpr float R = 0.70710678118654752f;
        constexpr float CK[8] = {1.f, R, 0.f, -R, -1.f, -R, 0.f, R}, SK[8] = {0.f, R, 1.f, R, 0.f, -R, -1.f, -R};
#pragma unroll
        for (int s = 0; s < 8; ++s) {
            float yr[2] = {0.f, 0.f}, yi[2] = {0.f, 0.f};
#pragma unroll
            for (int q = 0; q < 8; ++q) { const float ck = CK[(s * q) & 7], sk = SK[(s * q) & 7];
#pragma unroll
                for (int e = 0; e < 2; ++e) { yr[e] += zr[q][e] * ck + zi[q][e] * sk; yi[e] += zi[q][e] * ck - zr[q][e] * sk; } }
            float a[2], bq[2];
#pragma unroll
            for (int e = 0; e < 2; ++e) { const float rev = (float)(s * (2 * tid + e)) * (1.f / 8192.f); const float cs = cos_rev(rev), sn = sin_rev(rev);
                a[e] = yr[e] * cs + yi[e] * sn; bq[e] = yi[e] * cs - yr[e] * sn; }
            const size_t rho = (u < 4096) ? (size_t)((bg * 8 + s) * 128 + k2) : (size_t)(32768 + bg * 8 + s);
            *(unsigned*)(ZS + rho * 2048 + 2 * tid) = cvtpk(a[0], a[1]);
            *(unsigned*)(ZS + rho * 2048 + 1024 + 2 * tid) = cvtpk(bq[0], bq[1]);
        }
    }
}

__device__ __forceinline__ void phase_combine(const Params& p) {
    const int tid = tid_l(), lane = tid & 63, wid = tid >> 6, G = gridDim.x;
    const bf16_t* XR = (const bf16_t*)(p.ws + OFF_XR); const bf16_t* XR128 = (const bf16_t*)(p.ws + OFF_XR128); bf16_t* SG = (bf16_t*)(p.ws + OFF_SG);
    constexpr float NRM = 0.011048543456039806f;
    for (int r = blockIdx.x * 8 + wid; r < NLAT; r += G * 8) {
        const int b = r >> 13, k1 = r & (SEQ - 1), rm = b * SEQ + ((SEQ - k1) & (SEQ - 1));
        const bf16_t* x0 = XR + (size_t)r * 2048; const bf16_t* xm = XR + (size_t)rm * 2048; bf16_t* sg = SG + (size_t)r * 4096;
#pragma unroll
        for (int it = 0; it < 8; ++it) {
            const int c0 = (it * 64 + lane) * 8, g = c0 >> 8, k20 = c0 & 255;
            float f[8], gt[8]; unpack8(*(const u32x4*)(sg + c0), gt);
            if (k20 < 128) unpack8(*(const u32x4*)(x0 + g * 128 + k20), f);
            else {
#pragma unroll
                for (int j = 0; j < 8; ++j) { const int k2 = k20 + j; f[j] = (k2 == 128) ? bf2f(XR128[(size_t)r * 16 + g]) : bf2f(xm[g * 128 + 256 - k2]); } }
#pragma unroll
            for (int j = 0; j < 8; ++j) f[j] = f[j] * NRM * gt[j];
            *(u32x4*)(sg + c0) = pack8(f);
        }
    }
}

#define XB_TMO      128
#define XB_XCNT(j)  (256  + 64 * (j))
#define XB_XSUB(j)  (1280 + 64 * (j))
#define XB_XGEN(j)  (2304 + 64 * (j))
#define XB_TOP      3328
#define XB_TOPGEN   3392
#define XCD_BAR_WORDS 3456
#define XB_SPIN_CAP (1u << 20)
__device__ __forceinline__ unsigned xb_ld(unsigned* p)              { return __hip_atomic_load(p, __ATOMIC_RELAXED, __HIP_MEMORY_SCOPE_AGENT); }
__device__ __forceinline__ unsigned xb_add(unsigned* p, unsigned v) { return __hip_atomic_fetch_add(p, v, __ATOMIC_RELAXED, __HIP_MEMORY_SCOPE_AGENT); }
__device__ __forceinline__ unsigned xb_xcc_id() { return (unsigned)__builtin_amdgcn_s_getreg((3 << 11) | 20) & 0xFu; }
#define XB_SPIN(cond, bar) do { unsigned _sp = 0; while (cond) { __builtin_amdgcn_s_sleep(1); \
    if ((++_sp & 255u) == 0u) { if (xb_ld(&(bar)[XB_TMO])) break; if (_sp > XB_SPIN_CAP) { atomicAdd(&(bar)[XB_TMO], 1u); break; } } } } while (0)
struct XcdBarrier { unsigned* bar; unsigned x; volatile LAS unsigned* st; };
__device__ __forceinline__ XcdBarrier xcd_barrier_post(unsigned* bar, volatile LAS unsigned* st) {
    XcdBarrier b; b.bar = bar; b.x = xb_xcc_id(); b.st = st;
    if (threadIdx.x == 0) (void)xb_add(&bar[XB_XCNT(b.x)], 1u);
    return b;
}
__device__ __forceinline__ void xcd_barrier_complete(unsigned* bar, unsigned x, unsigned& nloc, unsigned& nx) {
    const unsigned G = gridDim.x * gridDim.y * gridDim.z;
    unsigned sum, cnt, mine, sp = 0u;
    for (;;) {
        sum = 0u; cnt = 0u; mine = 0u;
#pragma unroll
        for (unsigned j = 0; j < 16; ++j) { const unsigned c = xb_ld(&bar[XB_XCNT(j)]); sum += c; cnt += (c > 0u) ? 1u : 0u; mine = (j == x) ? c : mine; }
        if (sum == G) break;
        __builtin_amdgcn_s_sleep(1);
        if ((++sp & 255u) == 0u) { if (xb_ld(&bar[XB_TMO])) break; if (sp > XB_SPIN_CAP) { atomicAdd(&bar[XB_TMO], 1u); break; } }
    }
    nloc = mine > 0u ? mine : 1u; nx = cnt > 0u ? cnt : 1u;
}
__device__ __forceinline__ void xcd_barrier(const XcdBarrier& b) {
    asm volatile("s_waitcnt vmcnt(0)" ::: "memory");
    __syncthreads();
    if (threadIdx.x == 0) {
        unsigned* bar = b.bar;
        __builtin_amdgcn_s_waitcnt(0);
        unsigned nloc = b.st[0], nx = b.st[1];
        if (nloc == 0u) { xcd_barrier_complete(bar, b.x, nloc, nx); b.st[0] = nloc; b.st[1] = nx; }
        const unsigned old = xb_add(&bar[XB_XSUB(b.x)], 1u);
        const unsigned gen = old / nloc;
        if (old + 1u == (gen + 1u) * nloc) {
            __builtin_amdgcn_fence(__ATOMIC_RELEASE, "agent");
            asm volatile("s_waitcnt vmcnt(0)" ::: "memory");
            const unsigned og = xb_add(&bar[XB_TOP], 1u);
            const unsigned tg = og / nx;
            if (og + 1u == (tg + 1u) * nx) xb_add(&bar[XB_TOPGEN], 1u);
            else XB_SPIN(xb_ld(&bar[XB_TOPGEN]) == tg, bar);
            __builtin_amdgcn_fence(__ATOMIC_ACQUIRE, "agent");
            xb_add(&bar[XB_XGEN(b.x)], 1u);
            asm volatile("s_waitcnt vmcnt(0)" ::: "memory");
        } else {
            XB_SPIN(xb_ld(&bar[XB_XGEN(b.x)]) == gen, bar);
            __builtin_amdgcn_fence(__ATOMIC_ACQUIRE, "agent");
            asm volatile("s_waitcnt vmcnt(0)" ::: "memory");
        }
    }
    __syncthreads();
}

__global__ __launch_bounds__(512) void mega(Params p) {
    extern __shared__ __attribute__((aligned(16))) unsigned char shm[];
    cg::grid_group grid = cg::this_grid();
    LAS unsigned char* lds = (LAS unsigned char*)shm;
    unsigned char* ws = p.ws;
    const int G = gridDim.x, bid = blockIdx.x;
    const float* mod = (const float*)(ws + OFF_MOD);
    volatile LAS unsigned* bst = (volatile LAS unsigned*)(lds + LDS_STAGE);
    if (threadIdx.x < 2) bst[threadIdx.x] = 0u;
    __syncthreads();
    XcdBarrier xb; xb.bar = (unsigned*)(ws + OFF_BAR); xb.x = 0; xb.st = bst;
    for (int ph = p.ph_lo; ph < p.ph_hi; ++ph) {
      const int reps = (ph == REP_PH) ? 2 : 1;
      for (int rep = 0; rep < reps; ++rep) {
        const bool dry = rep + 1 < reps; (void)dry;
        if (rep) grid.sync();
        if (PH_ON(0) && ph == 0) phase_prep(p, (float*)shm);
        else if (PH_ON(1) && ph == 1) { phase_ln0(p); phase_fold(p, lds); }
        else if (PH_ON(2) && ph == 2) {
            pg8::Gemm gm{(const bf16_t*)(ws + OFF_H), (const bf16_t*)(ws + OFF_WI), NTOK, NWI, 2048, 2048, 2048};
            pg8::StaticOrder S; S.init(gm.M, gm.N, G, bid);
            pg8::EpiB<FZ> E{FZ{(bf16_t*)(ws + OFF_Z), (bf16_t*)(ws + OFF_SG0)}};
            pg8::gemm_phase(lds, gm, S, E);
        }
        else if (PH_ON(3) && ph == 3) phase_postz(p);
        else if (PH_ON(4) && ph == 4) {
            { pg8::Gemm gm{(const bf16_t*)(ws + OFF_CQN), (const bf16_t*)(ws + OFF_WQ), NLAT, 1536, 768, 768, 768};
              pg8::StaticOrder S; S.init(gm.M, gm.N, G, bid);
              pg8::EpiB<FQa> E{FQa{(bf16_t*)(ws + OFF_QA)}};
              pg8::gemm_phase(lds, gm, S, E); }
            { pg8::Gemm gm{(const bf16_t*)(ws + OFF_CKVN), (const bf16_t*)(ws + OFF_WKV), NTOK, 2048, 512, 512, 512};
              pg8::StaticOrder S; S.init(gm.M, gm.N, G, bid);
              pg8::EpiB<FKva> E{FKva{(bf16_t*)(ws + OFF_KA), (bf16_t*)(ws + OFF_VA)}};
              pg8::gemm_phase(lds, gm, S, E); }
        }
        else if (PH_ON(5) && ph == 5) {
            bf16_t* Y = (bf16_t*)(ws + OFF_SG0);
            for (int u = bid; u < 256; u += G) {
                const int head = u & 7, qblk = u >> 3;
                for (int b = 0; b < NB; ++b) {
                    const size_t t0 = (size_t)b * SEQ + qblk * 256;
                    attn_body<64, 1, 1536>((const bf16_t*)(ws + OFF_QA) + t0 * 1536 + head * 192,
                                           (const bf16_t*)(ws + OFF_KA) + (size_t)(b * 8 + head) * LKV * 128, (const bf16_t*)(ws + OFF_VA) + (size_t)(b * 8 + head) * LKV * 128,
                                           (const bf16_t*)(ws + OFF_KPE) + (size_t)b * LKV * 64, Y + t0 * 2048 + head * 128, LKV, (char*)shm, 0.07216878364870322f, dry);
                }
                for (int b = 0; b < NB; ++b) {
                    const size_t t0 = (size_t)b * SEQ + qblk * 256; const int kvh = head >> 2;
                    attn_body<0, 2, 1024>((const bf16_t*)(ws + OFF_QB) + t0 * 1024 + head * 128,
                                          (const bf16_t*)(ws + OFF_KB) + (size_t)(b * 2 + kvh) * LKV * 128, (const bf16_t*)(ws + OFF_VB) + (size_t)(b * 2 + kvh) * LKV * 128,
                                          nullptr, Y + t0 * 2048 + 1024 + head * 128, LKV, (char*)shm, 0.08838834764831845f, dry);
                }
            }
        }
        else if (PH_ON(6) && ph == 6) {
            pg8::Gemm gm{(const bf16_t*)(ws + OFF_SG0), (const bf16_t*)(ws + OFF_WO), NLAT, 2048, 2048, 2048, 2048};
            pg8::StaticOrder S; S.init(gm.M, gm.N, G, bid);
            pg8::EpiF<FRes> E{FRes{p.x, mod + 4096, p.out}};
            pg8::gemm_phase(lds, gm, S, E);
        }
        else if (PH_ON(7) && ph == 7) phase_ln1(p);
        else if (PH_ON(8) && ph == 8) {
            { pg8::Gemm gm{(const bf16_t*)(ws + OFF_WFU), (const bf16_t*)(ws + OFF_H1), 4096, NLAT, 2048, 2048, 2048};
              pg8::StaticOrder S; S.init(gm.M, gm.N, G, bid);
              pg8::EpiB<FStore> E{FStore{(bf16_t*)(ws + OFF_PT), NLAT}};
              pg8::gemm_phase(lds, gm, S, E); }
            { pg8::Gemm gm{(const bf16_t*)(ws + OFF_H1), (const bf16_t*)(ws + OFF_WFG), NLAT, 4096, 2048, 2048, 2048};
              pg8::StaticOrder S; S.init(gm.M, gm.N, G, bid);
              pg8::EpiB<FSilu> E{FSilu{(bf16_t*)(ws + OFF_SG), 4096}};
              pg8::gemm_phase(lds, gm, S, E); }
        }
        else if (PH_ON(9) && ph == 9) phase_radix8(p);
        else if (PH_ON(10) && ph == 10) {
            pg8::Gemm gm{(const bf16_t*)(ws + OFF_TRIG), (const bf16_t*)(ws + OFF_ZS), 1024, NZS, 2048, 2048, 2048};
            pg8::StaticOrder S; S.init(gm.M, gm.N, G, bid);
            pg8::EpiB<FXr> E{FXr{(bf16_t*)(ws + OFF_XR), (bf16_t*)(ws + OFF_XR128)}};
            pg8::gemm_phase(lds, gm, S, E);
        }
        else if (PH_ON(11) && ph == 11) phase_combine(p);
        else if (PH_ON(12) && ph == 12) {
            pg8::Gemm gm{(const bf16_t*)(ws + OFF_SG), (const bf16_t*)(ws + OFF_WOF), NLAT, 2048, 4096, 4096, 4096};
            pg8::StaticOrder S; S.init(gm.M, gm.N, G, bid);
            pg8::EpiF<FRes> E{FRes{p.out, mod + 3 * 6144 + 4096, p.out}};
            pg8::gemm_phase(lds, gm, S, E);
        }
        else if (PH_ON(13) && ph == 13) phase_ln2(p);
      }
        if (ph + 1 < p.ph_hi) {
            if (ph == 0) { grid.sync(); xb = xcd_barrier_post((unsigned*)(ws + OFF_BAR), bst); }
            else xcd_barrier(xb); }
    }
}

extern "C" void kernel_launch(void* const* d_in, const int* in_sizes, int n_in, void* d_out, int out_size, void* d_ws, size_t ws_size, hipStream_t stream) {
    static int grid = 0;
    if (grid == 0) {
        if (n_in != 18 || in_sizes[0] != NLAT * DM || out_size != NLAT * DM || ws_size < WS_NEED) {
            fprintf(stderr, "kernel_launch: shape/workspace mismatch (n_in %d, in0 %d, out %d, ws %zu, need %zu)\n", n_in, n_in > 0 ? in_sizes[0] : -1, out_size, ws_size, (size_t)WS_NEED); grid = -1; return; }
        int dev = 0, cus = 0, per_cu = 0;
        (void)hipGetDevice(&dev); (void)hipDeviceGetAttribute(&cus, hipDeviceAttributeMultiprocessorCount, dev);
        if (hipFuncSetAttribute((const void*)mega, hipFuncAttributeMaxDynamicSharedMemorySize, LDS_BYTES) != hipSuccess) { fprintf(stderr, "kernel_launch: hipFuncSetAttribute failed\n"); grid = -1; return; }
        if (hipOccupancyMaxActiveBlocksPerMultiprocessor(&per_cu, (const void*)mega, 512, LDS_BYTES) != hipSuccess || per_cu < 1) { fprintf(stderr, "kernel_launch: occupancy query says %d\n", per_cu); per_cu = 1; }
        (void)hipGetLastError();
        grid = cus * 1;
        if (grid > 256) grid = 256;
    }
    if (grid < 0) return;
    Params p{};
    p.x = (const float*)d_in[0]; p.c = (const float*)d_in[1]; p.ctx = (const float*)d_in[2]; p.c_ctx = (const float*)d_in[3]; p.ada_w = (const float*)d_in[4]; p.ada_b = (const float*)d_in[5];
    p.ln_g = (const float*)d_in[6]; p.ln_b = (const float*)d_in[7]; p.w_in_attn = (const float*)d_in[8]; p.wq_b = (const float*)d_in[9]; p.q_lora_g = (const float*)d_in[10];
    p.kv_lora_g = (const float*)d_in[11]; p.wkv_b = (const float*)d_in[12]; p.qn_g = (const float*)d_in[13]; p.kn_g = (const float*)d_in[14]; p.w_out_attn = (const float*)d_in[15];
    p.w_in_f = (const float*)d_in[16]; p.w_out_f = (const float*)d_in[17]; p.out = (float*)d_out; p.ws = (unsigned char*)d_ws;
#if MK_MULTI
    for (int ph = 0; ph < NPH; ++ph) { p.ph_lo = ph; p.ph_hi = ph + 1; hipLaunchKernelGGL(mega, dim3(grid), dim3(512), LDS_BYTES, stream, p); }
#else
    p.ph_lo = 0; p.ph_hi = NPH;
    void* args[] = {&p};
    hipError_t e = hipLaunchCooperativeKernel((const void*)mega, dim3(grid), dim3(512), args, LDS_BYTES, stream);
    if (e != hipSuccess) fprintf(stderr, "kernel_launch: cooperative launch failed: %s (grid %d)\n", hipGetErrorString(e), grid);
#endif
}
```

```cpp
#include <hip/hip_runtime.h>
#include <hip/hip_cooperative_groups.h>
#include <cstdio>
#include <cstdint>
namespace cg = cooperative_groups;

#ifndef MK_MULTI
#define MK_MULTI 0
#endif
#ifndef PHMASK
#define PHMASK 0xffff
#endif
#define PH_ON(n) ((PHMASK >> (n)) & 1)
#ifndef STAGGER_TICKS
#define STAGGER_TICKS 2200ull
#endif
#ifndef STAGGER_MASK
#define STAGGER_MASK 0x0
#endif
#ifndef REP_PH
#define REP_PH -1
#endif

typedef unsigned short bf16_t;
typedef short bf16x8 __attribute__((ext_vector_type(8)));
typedef short s16x4 __attribute__((ext_vector_type(4)));
typedef float f32x4 __attribute__((ext_vector_type(4)));
typedef float f32x16 __attribute__((ext_vector_type(16)));
typedef unsigned u32x4 __attribute__((ext_vector_type(4)));
typedef unsigned u32x2 __attribute__((ext_vector_type(2)));
#define LAS __attribute__((address_space(3)))

constexpr int DM = 2048, NB = 2, SEQ = 8192, CTX = 256, NLAT = NB * SEQ, NTOK = NLAT + NB * CTX, LKV = SEQ + CTX;
constexpr int ZW = 3072;
constexpr int NWI = 5120;
constexpr float ALPHA = 1.4142135623730951f;
constexpr int NPH = 14;
constexpr int LDS_STAGE = 131072;
constexpr int LDS_BYTES = LDS_STAGE + 256;

constexpr size_t al256(size_t x) { return (x + 255) / 256 * 256; }
constexpr size_t OFF_WI = 0;
constexpr size_t OFF_WQ = OFF_WI + (size_t)NWI * 2048 * 2;
constexpr size_t OFF_WKV = OFF_WQ + (size_t)1536 * 768 * 2;
constexpr size_t OFF_WO = OFF_WKV + (size_t)2048 * 512 * 2;
constexpr size_t OFF_WFU = OFF_WO + (size_t)2048 * 2048 * 2;
constexpr size_t OFF_WFG = OFF_WFU + (size_t)4096 * 2048 * 2;
constexpr size_t OFF_WOF = OFF_WFG + (size_t)4096 * 2048 * 2;
constexpr size_t OFF_WUB = OFF_WOF + (size_t)2048 * 4096 * 2;
constexpr size_t OFF_TT = OFF_WUB + (size_t)2048 * 4096 * 2;
constexpr size_t OFF_TRIG = OFF_TT + (size_t)256 * 256 * 2;
constexpr size_t OFF_MOD = OFF_TRIG + (size_t)1024 * 2048 * 2;
constexpr size_t OFF_BAR = al256(OFF_MOD + (size_t)2 * 3 * 6144 * 4);
constexpr size_t OFF_L = al256(OFF_BAR + (size_t)3456 * 4);
constexpr size_t OFF_H = OFF_L;
constexpr size_t OFF_CQN = OFF_H;
constexpr size_t OFF_CKVN = OFF_CQN + (size_t)NTOK * 768 * 2;
constexpr size_t OFF_Z = OFF_H + (size_t)NTOK * 2048 * 2;
constexpr size_t OFF_SG0 = OFF_Z + (size_t)NTOK * ZW * 2;
constexpr size_t OFF_QB = OFF_SG0 + (size_t)NTOK * 2048 * 2;
constexpr size_t OFF_KB = OFF_QB + (size_t)NTOK * 1024 * 2;
constexpr size_t OFF_VB = OFF_KB + (size_t)NB * 2 * LKV * 128 * 2;
constexpr size_t OFF_KPE = OFF_VB + (size_t)NB * 2 * LKV * 128 * 2;
constexpr size_t OFF_QA = OFF_KPE + (size_t)NB * LKV * 64 * 2;
constexpr size_t OFF_KA = OFF_QA + (size_t)NTOK * 1536 * 2;
constexpr size_t OFF_VA = OFF_KA + (size_t)NB * 8 * LKV * 128 * 2;
constexpr size_t OFF_DC = OFF_WI + (size_t)NB * CTX * DM * 4;
constexpr size_t OFF_XC = OFF_WI;
constexpr size_t OFF_D0 = OFF_Z;
constexpr size_t END0 = OFF_VA + (size_t)NB * 8 * LKV * 128 * 2;
constexpr int NZS = 66048;
constexpr size_t OFF_ZS = OFF_L;
constexpr size_t OFF_SG = OFF_ZS;
constexpr size_t OFF_PT = OFF_ZS + (size_t)NZS * 1024 * 2;
constexpr size_t OFF_XR = OFF_PT;
constexpr size_t OFF_XR128 = OFF_XR + (size_t)NLAT * 2048 * 2;
constexpr size_t OFF_H1 = OFF_PT + (size_t)4096 * NLAT * 2;
constexpr size_t OFF_D2 = OFF_H1 + (size_t)NLAT * 2048 * 2;
constexpr size_t END1 = OFF_D2 + (size_t)NLAT * 2048 * 2;
constexpr size_t WS_NEED = END0 > END1 ? END0 : END1;

struct Params {
    const float *x, *c, *ctx, *c_ctx, *ada_w, *ada_b, *ln_g, *ln_b, *w_in_attn, *wq_b, *q_lora_g, *kv_lora_g, *wkv_b, *qn_g, *kn_g, *w_out_attn, *w_in_f, *w_out_f;
    float* out; unsigned char* ws; int ph_lo, ph_hi;
};

__device__ __forceinline__ unsigned cvtpk(float lo, float hi) { unsigned r; asm("v_cvt_pk_bf16_f32 %0, %1, %2" : "=v"(r) : "v"(lo), "v"(hi)); return r; }
__device__ __forceinline__ int tid_l() { int t = threadIdx.x; asm volatile("" : "+v"(t)); return t; }
__device__ __forceinline__ int bid_l() { int t = blockIdx.x; asm volatile("" : "+s"(t)); return t; }
__device__ __forceinline__ float bflo(unsigned w) { return __uint_as_float(w << 16); }
__device__ __forceinline__ float bfhi(unsigned w) { return __uint_as_float(w & 0xffff0000u); }
__device__ __forceinline__ float bf2f(bf16_t b) { return __uint_as_float(((unsigned)b) << 16); }
__device__ __forceinline__ bf16_t f2bf(float f) { return (bf16_t)(cvtpk(f, 0.f) & 0xffffu); }
template <int O> __device__ __forceinline__ float xor_swz(float v) {
    return __int_as_float(__builtin_amdgcn_ds_swizzle(__float_as_int(v), 0x1F | (O << 10))); }
__device__ __forceinline__ float xor32(float v) {
    auto rr = __builtin_amdgcn_permlane32_swap(__float_as_uint(v), __float_as_uint(v), false, false);
    const float a = __uint_as_float(rr[0]), b = __uint_as_float(rr[1]);
    return (a == v) ? b : a;
}
__device__ __forceinline__ float sum16(float v) { v += xor_swz<8>(v); v += xor_swz<4>(v); v += xor_swz<2>(v); v += xor_swz<1>(v); return v; }
__device__ __forceinline__ float wave_sum(float v) {
    v += xor_swz<16>(v); v = sum16(v);
    auto rr = __builtin_amdgcn_permlane32_swap(__float_as_uint(v), __float_as_uint(v), false, false);
    return __uint_as_float(rr[0]) + __uint_as_float(rr[1]);
}
__device__ __forceinline__ float silu(float x) { return x / (1.f + __expf(-x)); }
__device__ __forceinline__ void unpack8(u32x4 w, float (&v)[8]) {
    v[0] = bflo(w.x); v[1] = bfhi(w.x); v[2] = bflo(w.y); v[3] = bfhi(w.y); v[4] = bflo(w.z); v[5] = bfhi(w.z); v[6] = bflo(w.w); v[7] = bfhi(w.w);
}
__device__ __forceinline__ u32x4 pack8(const float (&v)[8]) { u32x4 w; w.x = cvtpk(v[0], v[1]); w.y = cvtpk(v[2], v[3]); w.z = cvtpk(v[4], v[5]); w.w = cvtpk(v[6], v[7]); return w; }
__device__ __forceinline__ float cos_rev(float r) { return __builtin_amdgcn_cosf(r); }
__device__ __forceinline__ float sin_rev(float r) { return __builtin_amdgcn_sinf(r); }
__device__ __forceinline__ void rope8(float (&v)[8], int i0, int nhalf, float prow, float pcol) {
#pragma unroll
    for (int j = 0; j < 4; ++j) {
        const int i = i0 + j; const int fi = i < nhalf ? i : i - nhalf; const float pos = i < nhalf ? prow : pcol;
        const float inv = __builtin_amdgcn_exp2f(-(float)fi * (13.287712379549449f / (float)nhalf));
        const float rev = pos * inv * 0.15915494309189535f;
        const float cs = cos_rev(rev), sn = sin_rev(rev), a = v[2 * j], b = v[2 * j + 1];
        v[2 * j] = a * cs - b * sn; v[2 * j + 1] = a * sn + b * cs;
    }
}

namespace pg8 {
constexpr int BM = 256, BK = 64, HALF = 128, HTB = HALF * BK * 2, NXCD = 8, WGM = 7;
__device__ __forceinline__ int lds_byte(int r, int c) { const int st = (r >> 4) * 2 + (c >> 5), rr = r & 15, cc = c & 31, ob = rr * 64 + cc * 2; return st * 1024 + (ob ^ (((ob >> 9) & 1) << 5)); }
__device__ __forceinline__ void stage_rc(int b, int& R, int& C) { const int st = b / 1024, sb = b % 1024, swz = sb ^ (((sb >> 9) & 1) << 5); R = (st >> 1) * 16 + swz / 64; C = (st & 1) * 32 + (swz % 64) / 2; }
__device__ __forceinline__ int perm32(int rho) { const int n = rho >> 4, i = rho & 15; return 8 * (i >> 2) + 4 * n + (i & 3); }
struct Unit { int pm, pn; };
struct Gemm { const bf16_t* A; const bf16_t* Bt; int M, N, K, lda, ldb; };
struct StaticOrder {
    int nM, nN, nwg, G, c;
    __device__ void init(int M, int N, int G_, int c_) { nM = M / BM; nN = N / BM; nwg = nM * nN; G = G_; c = c_; }
    __device__ bool next(int i, Unit& u) const {
        const long L = (long)i * G + c; if (L >= nwg) return false;
        int wgid = (int)L; { const int q = nwg / NXCD, r = nwg % NXCD, xcd = wgid % NXCD, off = wgid / NXCD; wgid = (xcd < r ? xcd * (q + 1) : r * (q + 1) + (xcd - r) * q) + off; }
        const int nig = WGM * nN, gid = wgid / nig, fm = gid * WGM, gsz = (nM - fm) < WGM ? (nM - fm) : WGM;
        u.pm = fm + ((wgid % nig) % gsz); u.pn = (wgid % nig) / gsz; return true;
    }
};
struct MixOrder { StaticOrder so; int pm, pn; bool one, remap;
    __device__ bool next(int i, Unit& u) const {
        if (!one) { if (!so.next(i, u)) return false; if (remap && u.pm >= 61) { const int q = (u.pm - 61) * 20 + u.pn; u.pm = 61 + q / 12; u.pn = q % 12; } return true; }
        if (i) return false; u.pm = pm; u.pn = pn; return true; } };
struct OneUnit { int pm, pn; __device__ bool next(int i, Unit& u) const { if (i) return false; u.pm = pm; u.pn = pn; return true; } };

template <class Epi, class Sched>
__device__ __forceinline__ void gemm_phase(LAS unsigned char* lds, const Gemm g, const Sched& S, const Epi& E) {
    const int tid = tid_l(), wid = __builtin_amdgcn_readfirstlane(tid >> 6), lane = tid & 63, wr = wid >> 2, wc = wid & 3, fr = lane & 15, fq = lane >> 4;
    const int K = g.K, nt = K / BK;
    unsigned voffA[2], voffB[2];
#pragma unroll
    for (int i = 0; i < 2; ++i) { int R, C; stage_rc(tid * 16 + i * 8192, R, C); const int Rb = Epi::PERM ? ((R & ~31) + perm32(R & 31)) : R;
        voffA[i] = (unsigned)(R * g.lda + C) * 2u; voffB[i] = (unsigned)(Rb * g.ldb + C) * 2u; }
    const size_t kstep = (size_t)(BK * 2);
    const size_t hsA = (size_t)HALF * g.lda * 2, hsB = (size_t)HALF * g.ldb * 2;
    const size_t tsA = 2 * hsA, tsB = 2 * hsB;
    const unsigned ldsw = (unsigned)wid * 1024u;
    const int aoff = lds_byte(wr * 64 + fr, fq * 8), boff = lds_byte(wc * 32 + fr, fq * 8);
#define PG8_SA(b, h) (((b) * 2 + (h)) * HTB)
#define PG8_SB(b, h) ((4 + (b) * 2 + (h)) * HTB)
#define PG8_STAGE(bufoff, gbase, voff) do { _Pragma("unroll") for (int _i = 0; _i < 2; ++_i) \
        __builtin_amdgcn_global_load_lds((const unsigned*)((const char*)(gbase) + (voff)[_i]), (LAS unsigned*)(lds + (bufoff) + ldsw + _i * 8192), 16, 0, 0); } while (0)
#define PG8_LDA(dst, b, h) do { _Pragma("unroll") for (int m = 0; m < 4; ++m) _Pragma("unroll") for (int k = 0; k < 2; ++k) dst[m][k] = *(const LAS bf16x8*)(lds + PG8_SA(b, h) + aoff + m * 2048 + k * 1024); } while (0)
#define PG8_LDB(dst, b, h) do { _Pragma("unroll") for (int n = 0; n < 2; ++n) _Pragma("unroll") for (int k = 0; k < 2; ++k) dst[n][k] = *(const LAS bf16x8*)(lds + PG8_SB(b, h) + boff + n * 2048 + k * 1024); } while (0)
#define PG8_MMA(ai, bj, At, Bt) do { __builtin_amdgcn_s_setprio(1); _Pragma("unroll") for (int m = 0; m < 4; ++m) _Pragma("unroll") for (int n = 0; n < 2; ++n) _Pragma("unroll") for (int k = 0; k < 2; ++k) \
        acc[ai][bj][m][n] = __builtin_amdgcn_mfma_f32_16x16x32_bf16(Bt[n][k], At[m][k], acc[ai][bj][m][n], 0, 0, 0); __builtin_amdgcn_s_setprio(0); } while (0)
#define PG8_WAIT_V(n) asm volatile("s_waitcnt vmcnt(" #n ")" ::: "memory")
#define PG8_WAIT_L(n) asm volatile("s_waitcnt lgkmcnt(" #n ")" ::: "memory")
#define PG8_BAR __builtin_amdgcn_s_barrier()
#define PG8_SCHED __builtin_amdgcn_sched_barrier(0)
    Unit cur, nxt; int ui = 0;
    if (!S.next(0, cur)) return;
    f32x4 acc[2][2][4][2];
#pragma unroll
    for (int a = 0; a < 2; ++a)
#pragma unroll
        for (int b = 0; b < 2; ++b)
#pragma unroll
            for (int m = 0; m < 4; ++m)
#pragma unroll
                for (int n = 0; n < 2; ++n) acc[a][b][m][n] = (f32x4){0.f, 0.f, 0.f, 0.f};
    bf16x8 At[4][2], B0[2][2], B1[2][2];
    const char* cA = (const char*)g.A + (size_t)cur.pm * tsA; const char* cB = (const char*)g.Bt + (size_t)cur.pn * tsB;
    PG8_STAGE(PG8_SB(0, 0), cB, voffB); PG8_STAGE(PG8_SA(0, 0), cA, voffA); PG8_STAGE(PG8_SB(0, 1), cB + hsB, voffB); PG8_STAGE(PG8_SA(0, 1), cA + hsA, voffA);
    if (wr == 1) PG8_BAR;
    PG8_WAIT_V(4); PG8_BAR;
    PG8_STAGE(PG8_SB(1, 0), cB + kstep, voffB); PG8_STAGE(PG8_SA(1, 0), cA + kstep, voffA); PG8_STAGE(PG8_SB(1, 1), cB + hsB + kstep, voffB);
    PG8_WAIT_V(6); PG8_BAR;
    for (;;) {
        const bool has_next = S.next(ui + 1, nxt);
        const char* nA = has_next ? (const char*)g.A + (size_t)nxt.pm * tsA : cA; const char* nB = has_next ? (const char*)g.Bt + (size_t)nxt.pn * tsB : cB;
        for (int t = 0; t < nt; t += 2) {
            const bool last = (t == nt - 2);
            const char* a1 = cA + (size_t)(t + 1) * kstep;
            const char* a2 = last ? nA : cA + (size_t)(t + 2) * kstep; const char* b2 = last ? nB : cB + (size_t)(t + 2) * kstep;
            const char* a3 = a2 + kstep; const char* b3 = b2 + kstep;
            PG8_LDB(B0, 0, 0); PG8_SCHED; PG8_LDA(At, 0, 0); PG8_STAGE(PG8_SA(1, 1), a1 + hsA, voffA);
            PG8_WAIT_L(8); PG8_BAR; PG8_WAIT_L(0); PG8_MMA(0, 0, At, B0); PG8_BAR; PG8_SCHED;
            PG8_LDB(B1, 0, 1); PG8_STAGE(PG8_SB(0, 0), b2, voffB);
            PG8_BAR; PG8_WAIT_L(0); PG8_MMA(0, 1, At, B1); PG8_BAR;
            PG8_LDA(At, 0, 1); PG8_STAGE(PG8_SA(0, 0), a2, voffA);
            PG8_BAR; PG8_WAIT_L(0); PG8_MMA(1, 0, At, B0); PG8_BAR; PG8_SCHED;
            PG8_STAGE(PG8_SB(0, 1), b2 + hsB, voffB);
            PG8_WAIT_V(6); PG8_BAR; PG8_MMA(1, 1, At, B1); PG8_BAR;
            PG8_LDB(B0, 1, 0); PG8_SCHED; PG8_LDA(At, 1, 0); PG8_STAGE(PG8_SA(0, 1), a2 + hsA, voffA);
            PG8_WAIT_L(8); PG8_BAR; PG8_WAIT_L(0); PG8_MMA(0, 0, At, B0); PG8_BAR; PG8_SCHED;
            PG8_LDB(B1, 1, 1); PG8_STAGE(PG8_SB(1, 0), b3, voffB);
            PG8_BAR; PG8_WAIT_L(0); PG8_MMA(0, 1, At, B1); PG8_BAR;
            PG8_LDA(At, 1, 1); PG8_STAGE(PG8_SA(1, 0), a3, voffA);
            PG8_BAR; PG8_WAIT_L(0); PG8_MMA(1, 0, At, B0); PG8_BAR; PG8_SCHED;
            PG8_STAGE(PG8_SB(1, 1), b3 + hsB, voffB);
            PG8_WAIT_V(6); PG8_BAR; PG8_MMA(1, 1, At, B1); PG8_BAR;
        }
        E(acc, cur, wr, wc, fr, fq);
        if (!has_next) break;
#pragma unroll
        for (int a = 0; a < 2; ++a)
#pragma unroll
            for (int b = 0; b < 2; ++b)
#pragma unroll
                for (int m = 0; m < 4; ++m)
#pragma unroll
                    for (int n = 0; n < 2; ++n) acc[a][b][m][n] = (f32x4){0.f, 0.f, 0.f, 0.f};
        cur = nxt; cA = nA; cB = nB; ++ui;
    }
    PG8_WAIT_V(0);
    if (wr == 0) PG8_BAR;
    PG8_BAR;
#undef PG8_SA
#undef PG8_SB
#undef PG8_STAGE
#undef PG8_LDA
#undef PG8_LDB
#undef PG8_MMA
#undef PG8_WAIT_V
#undef PG8_WAIT_L
#undef PG8_BAR
#undef PG8_SCHED
}
template <class F> struct EpiB { static constexpr bool PERM = true; F f;
    __device__ __forceinline__ void operator()(const f32x4 (&acc)[2][2][4][2], const Unit& u, int wr, int wc, int fr, int fq) const {
#pragma unroll
        for (int ai = 0; ai < 2; ++ai)
#pragma unroll
            for (int m = 0; m < 4; ++m)
#pragma unroll
                for (int bj = 0; bj < 2; ++bj) {
                    const int row = u.pm * BM + ai * HALF + wr * 64 + m * 16 + fr, col = u.pn * BM + bj * HALF + wc * 32 + 8 * fq;
                    float v[8] = {acc[ai][bj][m][0][0], acc[ai][bj][m][0][1], acc[ai][bj][m][0][2], acc[ai][bj][m][0][3], acc[ai][bj][m][1][0], acc[ai][bj][m][1][1], acc[ai][bj][m][1][2], acc[ai][bj][m][1][3]};
                    f(row, col, v); }
    } };
template <class F> struct EpiF { static constexpr bool PERM = false; F f;
    __device__ __forceinline__ void operator()(const f32x4 (&acc)[2][2][4][2], const Unit& u, int wr, int wc, int fr, int fq) const {
#pragma unroll
        for (int ai = 0; ai < 2; ++ai)
#pragma unroll
            for (int m = 0; m < 4; ++m)
#pragma unroll
                for (int bj = 0; bj < 2; ++bj)
#pragma unroll
                    for (int n = 0; n < 2; ++n) {
                        const int row = u.pm * BM + ai * HALF + wr * 64 + m * 16 + fr, col = u.pn * BM + bj * HALF + wc * 32 + 16 * n + 4 * fq;
                        f(row, col, acc[ai][bj][m][n]); }
    } };
}

struct FStore { bf16_t* O; int ldc;
    __device__ __forceinline__ void operator()(int row, int col, float (&v)[8]) const { *(u32x4*)(O + (size_t)row * ldc + col) = pack8(v); } };
struct FSilu { bf16_t* O; int ldc;
    __device__ __forceinline__ void operator()(int row, int col, float (&v)[8]) const {
#pragma unroll
        for (int j = 0; j < 8; ++j) v[j] = silu(v[j]);
        *(u32x4*)(O + (size_t)row * ldc + col) = pack8(v); } };
struct FGate { const bf16_t* XR; const bf16_t* XR128; bf16_t* Y;
    __device__ __forceinline__ void operator()(int row, int col, float (&v)[8]) const {
        constexpr float NRM = 0.011048543456039806f;
        const int g = col >> 8, k20 = col & 255, b = row >> 13, k1 = row & (SEQ - 1);
        float f[8];
        if (k20 < 128) unpack8(*(const u32x4*)(XR + (size_t)row * 2048 + g * 128 + k20), f);
        else {
            const bf16_t* xm = XR + (size_t)(b * SEQ + ((SEQ - k1) & (SEQ - 1))) * 2048 + g * 128;
            float lo[8]; unpack8(*(const u32x4*)(xm + 248 - k20), lo);
#pragma unroll
            for (int j = 1; j < 8; ++j) f[j] = lo[8 - j];
            f[0] = (k20 == 128) ? bf2f(XR128[(size_t)row * 16 + g]) : bf2f(xm[256 - k20]);
        }
#pragma unroll
        for (int j = 0; j < 8; ++j) v[j] = silu(v[j]) * NRM * f[j];
        *(u32x4*)(Y + (size_t)row * 4096 + col) = pack8(v); } };
struct FZ { bf16_t* Z; bf16_t* SG0;
    __device__ __forceinline__ void operator()(int row, int col, float (&v)[8]) const {
        if (col < ZW) { *(u32x4*)(Z + (size_t)row * ZW + col) = pack8(v); }
        else {
#pragma unroll
            for (int j = 0; j < 8; ++j) v[j] = silu(v[j]);
            *(u32x4*)(SG0 + (size_t)row * 2048 + (col - ZW)) = pack8(v); } } };
struct FQa { bf16_t* Qa;
    __device__ __forceinline__ void operator()(int row, int col, float (&v)[8]) const {
        const int d = col % 192;
        if (d >= 128 && row < NLAT) { const int s = row & (SEQ - 1); rope8(v, (d - 128) >> 1, 16, (float)(s >> 6), (float)(s & 63)); }
        *(u32x4*)(Qa + (size_t)row * 1536 + col) = pack8(v); } };
struct FKva { bf16_t* Ka; bf16_t* Va;
    __device__ __forceinline__ void operator()(int row, int col, float (&v)[8]) const {
        const int head = col >> 8, dd = col & 255, d = dd & 127; int b, pos;
        if (row < NLAT) { b = row >> 13; pos = CTX + (row & (SEQ - 1)); } else { const int cr = row - NLAT; b = cr >> 8; pos = cr & 255; }
        bf16_t* dst = (dd >= 128 ? Va : Ka) + ((size_t)((b * 8 + head) * LKV + pos) * 128 + d);
        *(u32x4*)dst = pack8(v); } };
struct FRes { const float* xin; const float* gate; float* out;
    __device__ __forceinline__ void operator()(int row, int col, const f32x4& a) const {
        const int b = row >> 13; const size_t idx = (size_t)row * DM + col;
        const f32x4 xv = *(const f32x4*)(xin + idx), gv = *(const f32x4*)(gate + b * 6144 + col);
        *(f32x4*)(out + idx) = xv * ALPHA + gv * a; } };
struct FDelta { const float* gate; bf16_t* D; int ldd;
    __device__ __forceinline__ void operator()(int row, int col, float (&v)[8]) const {
        const int b = row < NLAT ? (row >> 13) : 2; const f32x4 g0 = *(const f32x4*)(gate + b * 6144 + col), g1 = *(const f32x4*)(gate + b * 6144 + col + 4);
        v[0] *= g0[0]; v[1] *= g0[1]; v[2] *= g0[2]; v[3] *= g0[3]; v[4] *= g1[0]; v[5] *= g1[1]; v[6] *= g1[2]; v[7] *= g1[3];
        *(u32x4*)(D + (size_t)row * ldd + col) = pack8(v); } };
struct FXr { bf16_t* XR; bf16_t* XR128;
    __device__ __forceinline__ void operator()(int row, int col, float (&v)[8]) const {
        if (col < 65536) { const int k2 = col & 127, s = (col >> 7) & 15, bg = col >> 11, b = bg >> 4, g = bg & 15;
            *(u32x4*)(XR + (size_t)(b * SEQ + 16 * row + s) * 2048 + g * 128 + k2) = pack8(v); }
        else { const int c = col - 65536, bg = c >> 4, s0 = c & 15, b = bg >> 4, g = bg & 15;
#pragma unroll
            for (int j = 0; j < 8; ++j) XR128[(size_t)(b * SEQ + 16 * row + s0 + j) * 16 + g] = f2bf(v[j]); } } };

#define KSWZ(row, colB) ((row) * 256 + ((colB) ^ (((row) & 7) << 4)))
#define XSWZ(row, colB) ((row) * 128 + ((colB) ^ (((row) & 7) << 4)))
#define SBAR() __builtin_amdgcn_sched_barrier(0)
constexpr int A_SHM_V = 64 * 128 * 2, A_SHM_K = 64 * 128 * 2, A_SHM_X = 64 * 64 * 2;
__device__ __forceinline__ unsigned cvtpk_v(float lo, float hi) { unsigned r; asm volatile("v_cvt_pk_bf16_f32 %0, %1, %2" : "=v"(r) : "v"(lo), "v"(hi)); return r; }
__device__ __forceinline__ int crow(int r, int hi) { return (r & 3) + 8 * (r >> 2) + 4 * hi; }
__device__ __forceinline__ void partialSM(f32x16& p0, f32x16& p1, float& m_reg, float& mn, float& alpha, const float SCALE) {
    const float C = SCALE * 1.4426950408889634f; const float THRS = 8.f / SCALE;
    float pmax = p0[0];
#pragma unroll
    for (int r = 1; r < 16; ++r) pmax = fmaxf(pmax, p0[r]);
#pragma unroll
    for (int r = 0; r < 16; ++r) pmax = fmaxf(pmax, p1[r]);
    { auto rr = __builtin_amdgcn_permlane32_swap(__float_as_uint(pmax), __float_as_uint(pmax), false, false);
      pmax = fmaxf(__uint_as_float(rr[0]), __uint_as_float(rr[1])); }
    if (__builtin_expect(__all(pmax - m_reg <= THRS), 1)) { mn = m_reg; alpha = 1.f; }
    else { mn = fmaxf(m_reg, pmax); alpha = __builtin_amdgcn_exp2f((m_reg - mn) * C); m_reg = mn; }
    const float mnC = -mn * C;
#pragma unroll
    for (int r = 0; r < 16; ++r) p0[r] = fmaf(p0[r], C, mnC);
#pragma unroll
    for (int r = 0; r < 16; ++r) p1[r] = fmaf(p1[r], C, mnC);
#pragma unroll
    for (int r = 0; r < 16; ++r) p0[r] = __builtin_amdgcn_exp2f(p0[r]);
}
__device__ __forceinline__ void finishSM(f32x16& p0, f32x16& p1, float alpha, float& l_reg, bf16x8& pa0, bf16x8& pa1, bf16x8& pa2, bf16x8& pa3) {
#pragma unroll
    for (int r = 0; r < 16; ++r) p1[r] = __builtin_amdgcn_exp2f(p1[r]);
    float ps = 0;
#pragma unroll
    for (int r = 0; r < 16; ++r) ps += p0[r];
#pragma unroll
    for (int r = 0; r < 16; ++r) ps += p1[r];
    { auto rr = __builtin_amdgcn_permlane32_swap(__float_as_uint(ps), __float_as_uint(ps), false, false);
      ps = __uint_as_float(rr[0]) + __uint_as_float(rr[1]); }
    l_reg = l_reg * alpha + ps;
#define PK4(P, BASE, OUT) do { unsigned a0 = cvtpk_v(P[BASE + 0], P[BASE + 1]), a1 = cvtpk_v(P[BASE + 2], P[BASE + 3]);   \
    unsigned b0 = cvtpk_v(P[BASE + 4], P[BASE + 5]), b1 = cvtpk_v(P[BASE + 6], P[BASE + 7]);                              \
    auto r0 = __builtin_amdgcn_permlane32_swap(a0, b0, false, false); auto r1 = __builtin_amdgcn_permlane32_swap(a1, b1, false, false); \
    u32x4 w = {r0[0], r1[0], r0[1], r1[1]}; OUT = *reinterpret_cast<bf16x8*>(&w); } while (0)
    PK4(p0, 0, pa0); PK4(p0, 8, pa1); PK4(p1, 0, pa2); PK4(p1, 8, pa3);
#undef PK4
}
template <int XD>
__device__ __forceinline__ void qkt(f32x16& p0, f32x16& p1, const char* Ks, const char* Xs, const bf16x8* qr, const bf16x8* qx, int r32, int hi) {
    p0 = f32x16{}; p1 = f32x16{};
#pragma unroll
    for (int d0 = 0; d0 < 8; ++d0) { const int cb = (d0 * 16 + hi * 8) * 2;
        bf16x8 b0 = *reinterpret_cast<const bf16x8*>(Ks + KSWZ(r32, cb));
        bf16x8 b1 = *reinterpret_cast<const bf16x8*>(Ks + KSWZ(32 + r32, cb));
        p0 = __builtin_amdgcn_mfma_f32_32x32x16_bf16(b0, qr[d0], p0, 0, 0, 0);
        p1 = __builtin_amdgcn_mfma_f32_32x32x16_bf16(b1, qr[d0], p1, 0, 0, 0); }
    if constexpr (XD > 0) {
#pragma unroll
        for (int d0 = 0; d0 < XD / 16; ++d0) { const int cb = (d0 * 16 + hi * 8) * 2;
            bf16x8 b0 = *reinterpret_cast<const bf16x8*>(Xs + XSWZ(r32, cb));
            bf16x8 b1 = *reinterpret_cast<const bf16x8*>(Xs + XSWZ(32 + r32, cb));
            p0 = __builtin_amdgcn_mfma_f32_32x32x16_bf16(b0, qx[d0], p0, 0, 0, 0);
            p1 = __builtin_amdgcn_mfma_f32_32x32x16_bf16(b1, qx[d0], p1, 0, 0, 0); }
    }
}
__device__ __forceinline__ int v_st(int k, int c) { const int kk = (k & ~0xC) | ((k & 4) << 1) | ((k & 8) >> 1); return ((kk >> 3) * 4 + (c >> 5)) * 512 + ((kk & 7) * 32 + (c & 31)) * 2; }
__device__ __forceinline__ int v_rd_base(int lane) { return ((lane & 3) << 3) | (((lane >> 2) & 3) << 6) | (((lane >> 4) & 1) << 5) | (((lane >> 5) & 1) << 8); }
constexpr int v_rd_off(int d0, int ks, int half) { return d0 * 512 + ks * 4096 + half * 2048; }
template <int OFF> __device__ __forceinline__ s16x4 tr_read(int vb) {
    s16x4 r; asm volatile("ds_read_b64_tr_b16 %0, %1 offset:%2" : "=&v"(r) : "v"(vb), "i"(OFF) : "memory"); return r;
}
template <int D0> __device__ __forceinline__ void pv_one(f32x16& od, int vb, bf16x8 pa0, bf16x8 pa1, bf16x8 pa2, bf16x8 pa3) {
    const s16x4 l0 = tr_read<v_rd_off(D0, 0, 0)>(vb), h0 = tr_read<v_rd_off(D0, 0, 1)>(vb), l1 = tr_read<v_rd_off(D0, 1, 0)>(vb), h1 = tr_read<v_rd_off(D0, 1, 1)>(vb);
    const s16x4 l2 = tr_read<v_rd_off(D0, 2, 0)>(vb), h2 = tr_read<v_rd_off(D0, 2, 1)>(vb), l3 = tr_read<v_rd_off(D0, 3, 0)>(vb), h3 = tr_read<v_rd_off(D0, 3, 1)>(vb);
    asm volatile("s_waitcnt lgkmcnt(0)" ::: "memory"); SBAR();
#define PK(L, H) (bf16x8){L[0], L[1], L[2], L[3], H[0], H[1], H[2], H[3]}
    od = __builtin_amdgcn_mfma_f32_32x32x16_bf16(pa0, PK(l0, h0), od, 0, 0, 0);
    od = __builtin_amdgcn_mfma_f32_32x32x16_bf16(pa1, PK(l1, h1), od, 0, 0, 0);
    od = __builtin_amdgcn_mfma_f32_32x32x16_bf16(pa2, PK(l2, h2), od, 0, 0, 0);
    od = __builtin_amdgcn_mfma_f32_32x32x16_bf16(pa3, PK(l3, h3), od, 0, 0, 0);
#undef PK
}
__device__ __forceinline__ void pv_d0(f32x16* o, int vb, bf16x8 pa0, bf16x8 pa1, bf16x8 pa2, bf16x8 pa3) {
    pv_one<0>(o[0], vb, pa0, pa1, pa2, pa3); pv_one<1>(o[1], vb, pa0, pa1, pa2, pa3); pv_one<2>(o[2], vb, pa0, pa1, pa2, pa3); pv_one<3>(o[3], vb, pa0, pa1, pa2, pa3);
}
template <int XD, int SDEPTH, int LDQ>
__device__ __forceinline__ void attn_body(const bf16_t* __restrict__ Qb, const bf16_t* __restrict__ Kh, const bf16_t* __restrict__ Vh, const bf16_t* __restrict__ Kx,
                                          bf16_t* __restrict__ Yb, int seq, char* lds, const float SCALE, const bool dry) {
    const int tid = tid_l(), wid = tid >> 6, lane = tid & 63, r32 = lane & 31, hi = lane >> 5;
    char* V_lds = lds; char* K_lds = lds + 2 * A_SHM_V; char* X_lds = lds + 2 * A_SHM_V + 2 * A_SHM_K;
    float* wsf = (float*)(lds + 2 * A_SHM_V + 2 * A_SHM_K + 2 * A_SHM_X) + wid * 64; float* li_l = wsf; float* al_l = wsf + 32;
    float m_reg = -1e30f, l_reg = 0; f32x16 o[4] = {}; bf16x8 qr[8]; bf16x8 qx[XD > 0 ? XD / 16 : 1];
    const bf16_t* Qw = Qb + (long)(wid * 32 + r32) * LDQ + hi * 8;
#pragma unroll
    for (int d0 = 0; d0 < 8; ++d0) qr[d0] = *reinterpret_cast<const bf16x8*>(Qw + d0 * 16);
    if constexpr (XD > 0) {
#pragma unroll
        for (int d0 = 0; d0 < XD / 16; ++d0) qx[d0] = *reinterpret_cast<const bf16x8*>(Qw + 128 + d0 * 16);
    }
    const int sr = tid >> 4, sc = (tid & 15) * 8, vst0 = v_st(sr, sc), vst1 = v_st(32 + sr, sc);
    const int xr = tid >> 3, xc = (tid & 7) * 8;
    const int vb0 = (int)(uintptr_t)V_lds + v_rd_base(lane);
    struct { bf16x8 vs0, vs1, ks0, ks1, xs; } sr_[SDEPTH];
#define SLOAD(i, k0) do { sr_[i].vs0 = *(const bf16x8*)(&Vh[(long)((k0) + sr) * 128 + sc]); sr_[i].vs1 = *(const bf16x8*)(&Vh[(long)((k0) + 32 + sr) * 128 + sc]); \
    sr_[i].ks0 = *(const bf16x8*)(&Kh[(long)((k0) + sr) * 128 + sc]); sr_[i].ks1 = *(const bf16x8*)(&Kh[(long)((k0) + 32 + sr) * 128 + sc]); \
    if constexpr (XD > 0) sr_[i].xs = *(const bf16x8*)(&Kx[(long)((k0) + xr) * 64 + xc]); } while (0)
#define SWRITE(b, i) do { *(bf16x8*)(V_lds + (b) * A_SHM_V + vst0) = sr_[i].vs0;          \
    *(bf16x8*)(V_lds + (b) * A_SHM_V + vst1) = sr_[i].vs1; int kc = sc * 2;               \
    *(bf16x8*)(K_lds + (b) * A_SHM_K + KSWZ(sr, kc)) = sr_[i].ks0;                       \
    *(bf16x8*)(K_lds + (b) * A_SHM_K + KSWZ(32 + sr, kc)) = sr_[i].ks1;                  \
    if constexpr (XD > 0) *(bf16x8*)(X_lds + (b) * A_SHM_X + XSWZ(xr, xc * 2)) = sr_[i].xs; } while (0)
#define SWAIT() do { if constexpr (SDEPTH == 2) { if constexpr (XD > 0) asm volatile("s_waitcnt vmcnt(5)" ::: "memory"); else asm volatile("s_waitcnt vmcnt(4)" ::: "memory"); } \
    else asm volatile("s_waitcnt vmcnt(0)" ::: "memory"); } while (0)
#define RESC(a) do { if (__any((a) < 1.f)) { if (hi == 0) al_l[r32] = (a); asm volatile("s_waitcnt lgkmcnt(0)" ::: "memory"); \
    _Pragma("unroll") for (int d = 0; d < 4; ++d) _Pragma("unroll") for (int r = 0; r < 16; ++r) o[d][r] *= al_l[crow(r, hi)]; } } while (0)
    f32x16 pA0, pA1, pB0, pB1; float mnA, mnB, alA, alB; bf16x8 pa0, pa1, pa2, pa3; const int NT = seq / 64;
    constexpr int SE = 0, SO = SDEPTH - 1;
    SLOAD(SE, 0); asm volatile("s_waitcnt vmcnt(0)" ::: "memory"); SWRITE(0, SE); __syncthreads();
    qkt<XD>(pA0, pA1, K_lds, X_lds, qr, qx, r32, hi); partialSM(pA0, pA1, m_reg, mnA, alA, SCALE);
    SLOAD(SO, 64); if constexpr (SDEPTH == 2) { if (2 < NT) SLOAD(SE, 2 * 64); }
    SWAIT(); SWRITE(1, SO); __syncthreads();
    for (int j = 1; j + 1 < NT; j += 2) {
        SBAR(); qkt<XD>(pB0, pB1, K_lds + A_SHM_K, X_lds + A_SHM_X, qr, qx, r32, hi);
        finishSM(pA0, pA1, alA, l_reg, pa0, pa1, pa2, pa3); SBAR();
        SLOAD(SO, (j + SDEPTH) * 64); SBAR();
        pv_d0(o, vb0, pa0, pa1, pa2, pa3); partialSM(pB0, pB1, m_reg, mnB, alB, SCALE);
        __syncthreads(); SWAIT(); SWRITE(0, SE);
        RESC(alB); __syncthreads();
        SBAR(); qkt<XD>(pA0, pA1, K_lds, X_lds, qr, qx, r32, hi);
        finishSM(pB0, pB1, alB, l_reg, pa0, pa1, pa2, pa3); SBAR();
        if (SDEPTH == 1 || j + 3 < NT) SLOAD(SE, (j + 1 + SDEPTH) * 64); SBAR();
        pv_d0(o, vb0 + A_SHM_V, pa0, pa1, pa2, pa3); partialSM(pA0, pA1, m_reg, mnA, alA, SCALE);
        __syncthreads(); SWAIT(); SWRITE(1, SO);
        RESC(alA); __syncthreads();
    }
    SBAR(); qkt<XD>(pB0, pB1, K_lds + A_SHM_K, X_lds + A_SHM_X, qr, qx, r32, hi);
    finishSM(pA0, pA1, alA, l_reg, pa0, pa1, pa2, pa3); SBAR();
    pv_d0(o, vb0, pa0, pa1, pa2, pa3); partialSM(pB0, pB1, m_reg, mnB, alB, SCALE);
    __syncthreads(); RESC(alB);
    finishSM(pB0, pB1, alB, l_reg, pa0, pa1, pa2, pa3); SBAR();
    pv_d0(o, vb0 + A_SHM_V, pa0, pa1, pa2, pa3);
    if (hi == 0) li_l[r32] = l_reg; asm volatile("s_waitcnt lgkmcnt(0)" ::: "memory");
    float rli[16];
#pragma unroll
    for (int r = 0; r < 16; ++r) rli[r] = __builtin_amdgcn_rcpf(li_l[crow(r, hi)]);
    bf16_t* Yw = Yb + (long)(wid * 32) * 2048;
    if (!dry)
#pragma unroll
    for (int r = 0; r < 16; ++r) { const int orow = crow(r, hi);
#pragma unroll
        for (int d0 = 0; d0 < 4; ++d0) { bf16_t* yp = Yw + (long)orow * 2048 + d0 * 32 + r32; *yp = f2bf(o[d0][r] * rli[r] * bf2f(*yp)); } }
    __syncthreads();
#undef SLOAD
#undef SWRITE
#undef SWAIT
#undef RESC
}

__device__ __forceinline__ void tconv_tile(const float* src, int ld, int k0, int sc0, bf16_t* dst, int ldd, int n0, float* tile) {
    const int tid = tid_l();
#pragma unroll
    for (int i = 0; i < 2; ++i) { const int r = (tid >> 4) + 32 * i, c = (tid & 15) * 4;
        f32x4 v = {0.f, 0.f, 0.f, 0.f}; if (sc0 >= 0) v = *(const f32x4*)(src + (size_t)(k0 + r) * ld + sc0 + c);
        tile[r * 65 + c] = v[0]; tile[r * 65 + c + 1] = v[1]; tile[r * 65 + c + 2] = v[2]; tile[r * 65 + c + 3] = v[3]; }
    __syncthreads();
    { const int n = tid >> 3, k8 = (tid & 7) * 8; float v[8];
#pragma unroll
      for (int j = 0; j < 8; ++j) v[j] = tile[(k8 + j) * 65 + n];
      *(u32x4*)(dst + (size_t)(n0 + n) * ldd + k0 + k8) = pack8(v); }
    __syncthreads();
}
__device__ __forceinline__ int wi_src(int n0) {
    if (n0 < 1280) return n0;
    if (n0 < 2304) return 1344 + (n0 - 1280);
    if (n0 < 2560) return 2368 + (n0 - 2304);
    if (n0 < 2816) return 2624 + (n0 - 2560);
    if (n0 < 2880) return 1280 + (n0 - 2816);
    if (n0 < 3072) return -1;
    return 2880 + (n0 - 3072);
}

__device__ __forceinline__ void phase_prep(const Params& p, float* ldsf) {
    const int tid = tid_l(), G = gridDim.x, bid = blockIdx.x, lane = tid & 63, wid = tid >> 6;
    unsigned char* ws = p.ws;
    if (bid == 0) { unsigned* bw = (unsigned*)(ws + OFF_BAR); for (int i = tid; i < 3456; i += 512) bw[i] = 0u; }
    float* sv = ldsf; float* red = ldsf + 3 * 2048;
    for (int i = tid; i < 3 * 2048; i += 512) { const int vec = i >> 11, k = i & 2047; const float v = vec < 2 ? p.c[vec * 2048 + k] : p.c_ctx[k]; sv[i] = silu(v); }
    __syncthreads();
    float* mod = (float*)(ws + OFF_MOD);
    for (int unit = bid; unit < 384; unit += G) {
        const int layer = unit / 192, col0 = (unit % 192) * 32, kc = tid >> 3, c4 = (tid & 7) * 4;
        const float* W = p.ada_w + (size_t)layer * 2048 * 6144 + col0 + c4;
        f32x4 a0 = {0, 0, 0, 0}, a1 = a0, a2 = a0;
#pragma unroll 4
        for (int i = 0; i < 32; ++i) { const int k = kc + 64 * i; const f32x4 w = *(const f32x4*)(W + (size_t)k * 6144);
            a0 += w * sv[k]; a1 += w * sv[2048 + k]; a2 += w * sv[4096 + k]; }
#pragma unroll
        for (int j = 0; j < 4; ++j) {
            a0[j] += xor_swz<8>(a0[j]); a1[j] += xor_swz<8>(a1[j]); a2[j] += xor_swz<8>(a2[j]);
            a0[j] += xor_swz<16>(a0[j]); a1[j] += xor_swz<16>(a1[j]); a2[j] += xor_swz<16>(a2[j]);
            { auto r0 = __builtin_amdgcn_permlane32_swap(__float_as_uint(a0[j]), __float_as_uint(a0[j]), false, false); a0[j] = __uint_as_float(r0[0]) + __uint_as_float(r0[1]);
              auto r1 = __builtin_amdgcn_permlane32_swap(__float_as_uint(a1[j]), __float_as_uint(a1[j]), false, false); a1[j] = __uint_as_float(r1[0]) + __uint_as_float(r1[1]);
              auto r2 = __builtin_amdgcn_permlane32_swap(__float_as_uint(a2[j]), __float_as_uint(a2[j]), false, false); a2[j] = __uint_as_float(r2[0]) + __uint_as_float(r2[1]); } }
        if (lane < 8) {
#pragma unroll
            for (int j = 0; j < 4; ++j) { red[(wid * 3 + 0) * 32 + c4 + j] = a0[j]; red[(wid * 3 + 1) * 32 + c4 + j] = a1[j]; red[(wid * 3 + 2) * 32 + c4 + j] = a2[j]; } }
        __syncthreads();
        if (tid < 96) { const int vec = tid >> 5, cc = tid & 31; float s = 0;
#pragma unroll
            for (int w = 0; w < 8; ++w) s += red[(w * 3 + vec) * 32 + cc];
            mod[(layer * 3 + vec) * 6144 + col0 + cc] = s + p.ada_b[layer * 6144 + col0 + cc]; }
        __syncthreads();
    }
    __syncthreads();
    float* tile = ldsf;
    for (int T = bid; T < 8224; T += G) {
        int t = T;
        if (t < 2560) { const int kt = t & 31, nt = t >> 5; tconv_tile(p.w_in_attn, 4928, kt * 64, wi_src(nt * 64), (bf16_t*)(ws + OFF_WI), 2048, nt * 64, tile); continue; }
        t -= 2560;
        if (t < 288) { const int kt = t % 12, nt = t / 12; tconv_tile(p.wq_b, 1536, kt * 64, nt * 64, (bf16_t*)(ws + OFF_WQ), 768, nt * 64, tile); continue; }
        t -= 288;
        if (t < 256) { const int kt = t & 7, nt = t >> 3; tconv_tile(p.wkv_b, 2048, kt * 64, nt * 64, (bf16_t*)(ws + OFF_WKV), 512, nt * 64, tile); continue; }
        t -= 256;
        if (t < 1024) { const int kt = t & 31, nt = t >> 5; tconv_tile(p.w_out_attn, 2048, kt * 64, nt * 64, (bf16_t*)(ws + OFF_WO), 2048, nt * 64, tile); continue; }
        t -= 1024;
        if (t < 2048) { const int kt = t & 31, nt = t >> 5; tconv_tile(p.w_in_f, 8192, kt * 64, 4096 + nt * 64, (bf16_t*)(ws + OFF_WFG), 2048, nt * 64, tile); continue; }
        t -= 2048;
        { const int kt = t & 63, nt = t >> 6; tconv_tile(p.w_out_f, 2048, kt * 64, nt * 64, (bf16_t*)(ws + OFF_WOF), 4096, nt * 64, tile); }
    }
    { bf16_t* Wub = (bf16_t*)(ws + OFF_WUB);
      for (int i = bid * 512 + tid; i < 2048 * 512; i += G * 512) { const int k = i >> 9, c8 = (i & 511) * 8;
          const f32x4 a = *(const f32x4*)(p.w_in_f + (size_t)k * 8192 + c8), b = *(const f32x4*)(p.w_in_f + (size_t)k * 8192 + c8 + 4);
          float v[8] = {a[0], a[1], a[2], a[3], b[0], b[1], b[2], b[3]}; *(u32x4*)(Wub + (size_t)k * 4096 + c8) = pack8(v); } }
    { bf16_t* Tt = (bf16_t*)(ws + OFF_TT);
      for (int i = bid * 512 + tid; i < 65536; i += G * 512) { const int j = i >> 8, n2 = i & 255; const int jj = j <= 128 ? j : j - 128;
          const float rev = (float)((jj * n2) & 255) * (1.f / 256.f); const float v = (j <= 128 ? cos_rev(rev) : sin_rev(rev)) * 0.0625f; Tt[i] = f2bf(v); } }
    { bf16_t* Tr = (bf16_t*)(ws + OFF_TRIG);
      for (int i = bid * 512 + tid; i < 512 * 1024; i += G * 512) { const int m = i >> 10, n = i & 1023, np = n & 511;
          const float rev = (float)((m * np) & 511) * (1.f / 512.f); Tr[i] = f2bf(n < 512 ? cos_rev(rev) : sin_rev(rev)); } }
}

__device__ __forceinline__ void row_stats(const f32x4 (&v)[8], float& mean, float& rstd) {
    float s = 0;
#pragma unroll
    for (int i = 0; i < 8; ++i) s += v[i][0] + v[i][1] + v[i][2] + v[i][3];
    mean = wave_sum(s) * (1.f / 2048.f);
    float q = 0;
#pragma unroll
    for (int i = 0; i < 8; ++i) { const f32x4 d = v[i] - mean; q += d[0] * d[0] + d[1] * d[1] + d[2] * d[2] + d[3] * d[3]; }
    rstd = rsqrtf(wave_sum(q) * (1.f / 2048.f) + 1e-6f);
}
__device__ __forceinline__ void mod_store(const f32x4 (&v)[8], float mean, float rstd, const float* shift, const float* scale, bf16_t* hr, int lane) {
#pragma unroll
    for (int i = 0; i < 8; ++i) { const int c = i * 256 + lane * 4; const f32x4 sc = *(const f32x4*)(scale + c), sh = *(const f32x4*)(shift + c);
        const f32x4 y = (v[i] - mean) * rstd * (sc + 1.f) + sh; u32x2 w; w.x = cvtpk(y[0], y[1]); w.y = cvtpk(y[2], y[3]); *(u32x2*)(hr + c) = w; }
}

__device__ __forceinline__ void phase_ln0(const Params& p) {
    const int tid = tid_l(), lane = tid & 63, wid = tid >> 6, G = gridDim.x;
    const float* mod = (const float*)(p.ws + OFF_MOD); bf16_t* H = (bf16_t*)(p.ws + OFF_H);
    for (int r = blockIdx.x * 8 + wid; r < NTOK; r += G * 8) {
        const float* xr; int vec;
        if (r < NLAT) { xr = p.x + (size_t)r * DM; vec = r >> 13; } else { xr = p.ctx + (size_t)(r - NLAT) * DM; vec = 2; }
        f32x4 v[8];
#pragma unroll
        for (int i = 0; i < 8; ++i) v[i] = *(const f32x4*)(xr + i * 256 + lane * 4);
        float mean, rstd; row_stats(v, mean, rstd);
        mod_store(v, mean, rstd, mod + vec * 6144, mod + vec * 6144 + 2048, H + (size_t)r * DM, lane);
    }
}
__device__ __forceinline__ void phase_fold(const Params& p, LAS unsigned char* lds, int first_wg) {
    for (int w = (int)blockIdx.x - first_wg; w >= 0 && w < 128; w += (int)gridDim.x - first_wg) {
        const int g = w >> 3;
        pg8::Gemm gm{(const bf16_t*)(p.ws + OFF_TT), (const bf16_t*)(p.ws + OFF_WUB) + g * 256, 256, 2048, 256, 256, 4096};
        pg8::OneUnit S{0, w & 7};
        pg8::EpiB<FStore> E{FStore{(bf16_t*)(p.ws + OFF_WFU) + (size_t)g * 256 * 2048, 2048}};
        pg8::gemm_phase(lds, gm, S, E);
    }
}

__device__ __forceinline__ void phase_postz(const Params& p) {
    const int tid = tid_l(), lane = tid & 63, wid = tid >> 6, G = gridDim.x;
    unsigned char* ws = p.ws;
    const bf16_t* Z = (const bf16_t*)(ws + OFF_Z);
    bf16_t* CQN = (bf16_t*)(ws + OFF_CQN); bf16_t* CKVN = (bf16_t*)(ws + OFF_CKVN); bf16_t* QB = (bf16_t*)(ws + OFF_QB);
    bf16_t* KB = (bf16_t*)(ws + OFF_KB); bf16_t* VB = (bf16_t*)(ws + OFF_VB); bf16_t* KPE = (bf16_t*)(ws + OFF_KPE);
    for (int r = ((int)blockIdx.x - 40) * 8 + wid; r < NTOK; r += (G - 40) * 8) {
        const bf16_t* zr = Z + (size_t)r * ZW; const bool lat = r < NLAT; int b, pos, s;
        if (lat) { b = r >> 13; s = r & (SEQ - 1); pos = CTX + s; } else { const int cr = r - NLAT; b = cr >> 8; pos = cr & 255; s = 0; }
        const float prow = (float)(s >> 6), pcol = (float)(s & 63);
        float v[8];
        {
            float v2[8]; unpack8(*(const u32x4*)(zr + lane * 8), v); float ss = 0;
#pragma unroll
            for (int j = 0; j < 8; ++j) ss += v[j] * v[j];
            if (lane < 32) { unpack8(*(const u32x4*)(zr + 512 + lane * 8), v2);
#pragma unroll
                for (int j = 0; j < 8; ++j) ss += v2[j] * v2[j]; }
            const float rstd = rsqrtf(wave_sum(ss) * (1.f / 768.f) + 1e-6f);
#pragma unroll
            for (int j = 0; j < 8; ++j) v[j] = v[j] * rstd * p.q_lora_g[lane * 8 + j];
            *(u32x4*)(CQN + (size_t)r * 768 + lane * 8) = pack8(v);
            if (lane < 32) {
#pragma unroll
                for (int j = 0; j < 8; ++j) v2[j] = v2[j] * rstd * p.q_lora_g[512 + lane * 8 + j];
                *(u32x4*)(CQN + (size_t)r * 768 + 512 + lane * 8) = pack8(v2); }
        }
        {
            unpack8(*(const u32x4*)(zr + 768 + lane * 8), v); float ss = 0;
#pragma unroll
            for (int j = 0; j < 8; ++j) ss += v[j] * v[j];
            const float rstd = rsqrtf(wave_sum(ss) * (1.f / 512.f) + 1e-6f);
#pragma unroll
            for (int j = 0; j < 8; ++j) v[j] = v[j] * rstd * p.kv_lora_g[lane * 8 + j];
            *(u32x4*)(CKVN + (size_t)r * 512 + lane * 8) = pack8(v);
        }
        const int d = (lane & 15) * 8;
        {
#pragma unroll
            for (int ps = 0; ps < 2; ++ps) {
                unpack8(*(const u32x4*)(zr + 1280 + ps * 512 + lane * 8), v); float ss = 0;
#pragma unroll
                for (int j = 0; j < 8; ++j) ss += v[j] * v[j];
                const float rstd = rsqrtf(sum16(ss) * (1.f / 128.f) + 1e-6f);
#pragma unroll
                for (int j = 0; j < 8; ++j) v[j] = v[j] * rstd * p.qn_g[d + j];
                if (lat) rope8(v, d >> 1, 32, prow, pcol);
                *(u32x4*)(QB + (size_t)r * 1024 + ps * 512 + lane * 8) = pack8(v);
            }
        }
        {
            unpack8(*(const u32x4*)(zr + 2304 + lane * 8), v); float ss = 0;
#pragma unroll
            for (int j = 0; j < 8; ++j) ss += v[j] * v[j];
            const float rstd = rsqrtf(sum16(ss) * (1.f / 128.f) + 1e-6f);
            const int head = (lane >> 4) & 1; const bool isV = lane >= 32;
            if (!isV) {
#pragma unroll
                for (int j = 0; j < 8; ++j) v[j] = v[j] * rstd * p.kn_g[d + j];
                if (lat) rope8(v, d >> 1, 32, prow, pcol);
            }
            bf16_t* dst = (isV ? VB : KB) + ((size_t)((b * 2 + head) * LKV + pos) * 128 + d);
            *(u32x4*)dst = pack8(v);
        }
        if (lane < 8) {
            unpack8(*(const u32x4*)(zr + 2816 + lane * 8), v);
            if (lat) rope8(v, lane * 4, 16, prow, pcol);
            *(u32x4*)(KPE + (size_t)(b * LKV + pos) * 64 + lane * 8) = pack8(v);
        }
    }
}

__device__ __forceinline__ void phase_ln1(const Params& p) {
    const int tid = tid_l(), lane = tid & 63, wid = tid >> 6, G = gridDim.x;
    const float* mod1 = (const float*)(p.ws + OFF_MOD) + 3 * 6144; bf16_t* H1 = (bf16_t*)(p.ws + OFF_H1); const bf16_t* D0 = (const bf16_t*)p.out + 2048;
    for (int r = ((int)blockIdx.x - 16) * 8 + wid; r < NLAT; r += (G - 16) * 8) {
        const int vec = r >> 13; const float* xin = p.x + (size_t)r * DM; const bf16_t* dr = D0 + (size_t)r * 4096;
        f32x4 v[8];
#pragma unroll
        for (int i = 0; i < 8; ++i) { const int c = i * 256 + lane * 4; const f32x4 xv = *(const f32x4*)(xin + c); const u32x2 dw = *(const u32x2*)(dr + c);
            v[i] = xv * ALPHA + (f32x4){bflo(dw.x), bfhi(dw.x), bflo(dw.y), bfhi(dw.y)}; }
        float mean, rstd; row_stats(v, mean, rstd);
#pragma unroll
        for (int i = 0; i < 8; ++i) { const int c = i * 256 + lane * 4; const f32x4 g = *(const f32x4*)(p.ln_g + c), bb = *(const f32x4*)(p.ln_b + c);
            v[i] = (v[i] - mean) * rstd * g + bb; }
        row_stats(v, mean, rstd);
        mod_store(v, mean, rstd, mod1 + vec * 6144, mod1 + vec * 6144 + 2048, H1 + (size_t)r * DM, lane);
    }
}
__device__ __forceinline__ void phase_xc(const Params& p) {
    const int tid = tid_l(), lane = tid & 63, wid = tid >> 6, G = gridDim.x;
    const bf16_t* DC = (const bf16_t*)(p.ws + OFF_DC); float* XC = (float*)(p.ws + OFF_XC);
    for (int r = blockIdx.x * 8 + wid; r < NB * CTX; r += G * 8) {
        const float* xin = p.ctx + (size_t)r * DM; const bf16_t* dr = DC + (size_t)r * DM;
        f32x4 v[8];
#pragma unroll
        for (int i = 0; i < 8; ++i) { const int c = i * 256 + lane * 4; const f32x4 xv = *(const f32x4*)(xin + c); const u32x2 dw = *(const u32x2*)(dr + c);
            v[i] = xv * ALPHA + (f32x4){bflo(dw.x), bfhi(dw.x), bflo(dw.y), bfhi(dw.y)}; }
        float mean, rstd; row_stats(v, mean, rstd);
#pragma unroll
        for (int i = 0; i < 8; ++i) { const int c = i * 256 + lane * 4; const f32x4 g = *(const f32x4*)(p.ln_g + c), bb = *(const f32x4*)(p.ln_b + c);
            *(f32x4*)(XC + (size_t)r * DM + c) = (v[i] - mean) * rstd * g + bb; }
    }
}
__device__ __forceinline__ void phase_ln2(const Params& p) {
    const int tid = tid_l(), lane = tid & 63, wid = tid >> 6, G = gridDim.x;
    for (int r = blockIdx.x * 8 + wid; r < NLAT; r += G * 8) {
        float* xr = p.out + (size_t)r * DM; const float* xin = p.x + (size_t)r * DM;
        const bf16_t* d0r = (const bf16_t*)p.out + (size_t)r * 4096 + 2048; const bf16_t* d2r = (const bf16_t*)(p.ws + OFF_D2) + (size_t)r * DM;
        f32x4 v[8]; u32x2 d2w[8];
#pragma unroll
        for (int i = 0; i < 8; ++i) { const int c = i * 256 + lane * 4; const f32x4 xv = *(const f32x4*)(xin + c); const u32x2 dw = *(const u32x2*)(d0r + c); d2w[i] = *(const u32x2*)(d2r + c);
            v[i] = xv * ALPHA + (f32x4){bflo(dw.x), bfhi(dw.x), bflo(dw.y), bfhi(dw.y)}; }
        float mean, rstd; row_stats(v, mean, rstd);
#pragma unroll
        for (int i = 0; i < 8; ++i) { const int c = i * 256 + lane * 4; const f32x4 g = *(const f32x4*)(p.ln_g + c), bb = *(const f32x4*)(p.ln_b + c);
            const f32x4 x1 = (v[i] - mean) * rstd * g + bb;
            v[i] = x1 * ALPHA + (f32x4){bflo(d2w[i].x), bfhi(d2w[i].x), bflo(d2w[i].y), bfhi(d2w[i].y)}; }
        row_stats(v, mean, rstd);
#pragma unroll
        for (int i = 0; i < 8; ++i) { const int c = i * 256 + lane * 4; const f32x4 g = *(const f32x4*)(p.ln_g + DM + c), bb = *(const f32x4*)(p.ln_b + DM + c);
            *(f32x4*)(xr + c) = (v[i] - mean) * rstd * g + bb; }
    }
}

__device__ __forceinline__ void dft4(const float (&xr)[4][2], const float (&xi)[4][2], float (&tr)[4][2], float (&ti)[4][2]) {
#pragma unroll
    for (int e = 0; e < 2; ++e) {
        const float ar = xr[0][e] + xr[2][e], ai = xi[0][e] + xi[2][e], br = xr[0][e] - xr[2][e], bi = xi[0][e] - xi[2][e];
        const float cr = xr[1][e] + xr[3][e], ci = xi[1][e] + xi[3][e], dr = xr[1][e] - xr[3][e], di = xi[1][e] - xi[3][e];
        tr[0][e] = ar + cr; ti[0][e] = ai + ci;
        tr[2][e] = ar - cr; ti[2][e] = ai - ci;
        tr[1][e] = br + di; ti[1][e] = bi - dr;
        tr[3][e] = br - di; ti[3][e] = bi + dr;
    }
}
__device__ __forceinline__ void phase_radix16(const Params& p) {
    const int tid = tid_l(), G = gridDim.x, half = tid >> 8, np = (tid & 255) * 2;
    const bf16_t* PT = (const bf16_t*)(p.ws + OFF_PT); bf16_t* ZS = (bf16_t*)(p.ws + OFF_ZS);
    unsigned pw[16], qw[16];
    auto issue = [&](int u) {
        int bg, k2; if (u < 2048) { bg = u >> 6; k2 = (u & 63) * 2 + half; } else { bg = (u - 2048) * 2 + half; k2 = 128; }
        const int b = bg >> 4, g = bg & 15;
        const bf16_t* Pp = PT + (size_t)(g * 256 + k2) * NLAT + b * SEQ + np;
        const bool hasQ = (k2 >= 1 && k2 <= 127);
        const bf16_t* Qp = PT + (size_t)(g * 256 + 128 + k2) * NLAT + b * SEQ + np;
#pragma unroll
        for (int q = 0; q < 16; ++q) { pw[q] = *(const unsigned*)(Pp + 512 * q); qw[q] = hasQ ? *(const unsigned*)(Qp + 512 * q) : 0u; }
    };
    if ((int)blockIdx.x < 2064) issue(blockIdx.x);
    for (int u = blockIdx.x; u < 2064; u += G) {
        int bg, k2; if (u < 2048) { bg = u >> 6; k2 = (u & 63) * 2 + half; } else { bg = (u - 2048) * 2 + half; k2 = 128; }
        float zr[16][2], zi[16][2];
#pragma unroll
        for (int q = 0; q < 16; ++q) { zr[q][0] = bflo(pw[q]); zr[q][1] = bfhi(pw[q]); zi[q][0] = -bflo(qw[q]); zi[q][1] = -bfhi(qw[q]); }
        if (u + G < 2064) issue(u + G);
        float ur[4][4][2], ui[4][4][2];
#pragma unroll
        for (int q0 = 0; q0 < 4; ++q0) {
            float xr[4][2], xi[4][2], tr[4][2], ti[4][2];
#pragma unroll
            for (int q1 = 0; q1 < 4; ++q1) { xr[q1][0] = zr[4 * q1 + q0][0]; xr[q1][1] = zr[4 * q1 + q0][1]; xi[q1][0] = zi[4 * q1 + q0][0]; xi[q1][1] = zi[4 * q1 + q0][1]; }
            dft4(xr, xi, tr, ti);
#pragma unroll
            for (int s0 = 0; s0 < 4; ++s0) {
                constexpr float C16[10] = {1.f, 0.92387953251128674f, 0.70710678118654752f, 0.38268343236508977f, 0.f, -0.38268343236508977f, -0.70710678118654752f, -0.92387953251128674f, -1.f, -0.92387953251128674f};
                constexpr float S16[10] = {0.f, 0.38268343236508977f, 0.70710678118654752f, 0.92387953251128674f, 1.f, 0.92387953251128674f, 0.70710678118654752f, 0.38268343236508977f, 0.f, -0.38268343236508977f};
                const float ck = C16[s0 * q0], sk = S16[s0 * q0];
#pragma unroll
                for (int e = 0; e < 2; ++e) { ur[q0][s0][e] = tr[s0][e] * ck + ti[s0][e] * sk; ui[q0][s0][e] = ti[s0][e] * ck - tr[s0][e] * sk; }
            }
        }
#pragma unroll
        for (int s0 = 0; s0 < 4; ++s0) {
            float xr[4][2], xi[4][2], yr[4][2], yi[4][2];
#pragma unroll
            for (int q0 = 0; q0 < 4; ++q0) { xr[q0][0] = ur[q0][s0][0]; xr[q0][1] = ur[q0][s0][1]; xi[q0][0] = ui[q0][s0][0]; xi[q0][1] = ui[q0][s0][1]; }
            dft4(xr, xi, yr, yi);
#pragma unroll
            for (int s1 = 0; s1 < 4; ++s1) {
                const int sq = s0 + 4 * s1; float a[2], bq[2];
#pragma unroll
                for (int e = 0; e < 2; ++e) { const float rev = (float)(sq * (np + e)) * (1.f / 8192.f); const float cs = cos_rev(rev), sn = sin_rev(rev);
                    a[e] = yr[s1][e] * cs + yi[s1][e] * sn; bq[e] = yi[s1][e] * cs - yr[s1][e] * sn; }
                const size_t rho = (u < 2048) ? (size_t)((bg * 16 + sq) * 128 + k2) : (size_t)(65536 + bg * 16 + sq);
                *(unsigned*)(ZS + rho * 1024 + np) = cvtpk(a[0], a[1]);
                *(unsigned*)(ZS + rho * 1024 + 512 + np) = cvtpk(bq[0], bq[1]);
            }
        }
    }
}

__device__ __forceinline__ void phase_combine(const Params& p) {
    const int tid = tid_l(), lane = tid & 63, wid = tid >> 6, G = gridDim.x;
    const bf16_t* XR = (const bf16_t*)(p.ws + OFF_XR); const bf16_t* XR128 = (const bf16_t*)(p.ws + OFF_XR128); bf16_t* SG = (bf16_t*)(p.ws + OFF_SG);
    constexpr float NRM = 0.011048543456039806f;
    for (int r = blockIdx.x * 8 + wid; r < NLAT; r += G * 8) {
        const int b = r >> 13, k1 = r & (SEQ - 1), rm = b * SEQ + ((SEQ - k1) & (SEQ - 1));
        const bf16_t* x0 = XR + (size_t)r * 2048; const bf16_t* xm = XR + (size_t)rm * 2048; bf16_t* sg = SG + (size_t)r * 4096;
#pragma unroll
        for (int it = 0; it < 8; ++it) {
            const int c0 = (it * 64 + lane) * 8, g = c0 >> 8, k20 = c0 & 255;
            float f[8], gt[8]; unpack8(*(const u32x4*)(sg + c0), gt);
            if (k20 < 128) unpack8(*(const u32x4*)(x0 + g * 128 + k20), f);
            else {
#pragma unroll
                for (int j = 0; j < 8; ++j) { const int k2 = k20 + j; f[j] = (k2 == 128) ? bf2f(XR128[(size_t)r * 16 + g]) : bf2f(xm[g * 128 + 256 - k2]); } }
#pragma unroll
            for (int j = 0; j < 8; ++j) f[j] = f[j] * NRM * gt[j];
            *(u32x4*)(sg + c0) = pack8(f);
        }
    }
}

#define XB_TMO      128
#define XB_XCNT(j)  (256  + 64 * (j))
#define XB_XSUB(j)  (1280 + 64 * (j))
#define XB_XGEN(j)  (2304 + 64 * (j))
#define XB_TOP      3328
#define XB_TOPGEN   3392
#define XCD_BAR_WORDS 3456
#define XB_SPIN_CAP (1u << 20)
__device__ __forceinline__ unsigned xb_ld(unsigned* p)              { return __hip_atomic_load(p, __ATOMIC_RELAXED, __HIP_MEMORY_SCOPE_AGENT); }
__device__ __forceinline__ unsigned xb_add(unsigned* p, unsigned v) { return __hip_atomic_fetch_add(p, v, __ATOMIC_RELAXED, __HIP_MEMORY_SCOPE_AGENT); }
__device__ __forceinline__ unsigned xb_xcc_id() { return (unsigned)__builtin_amdgcn_s_getreg((3 << 11) | 20) & 0xFu; }
#define XB_SPIN(cond, bar) do { unsigned _sp = 0; while (cond) { __builtin_amdgcn_s_sleep(1); \
    if ((++_sp & 255u) == 0u) { if (xb_ld(&(bar)[XB_TMO])) break; if (_sp > XB_SPIN_CAP) { atomicAdd(&(bar)[XB_TMO], 1u); break; } } } } while (0)
struct XcdBarrier { unsigned* bar; unsigned x; volatile LAS unsigned* st; };
__device__ __forceinline__ XcdBarrier xcd_barrier_post(unsigned* bar, volatile LAS unsigned* st) {
    XcdBarrier b; b.bar = bar; b.x = xb_xcc_id(); b.st = st;
    if (threadIdx.x == 0) (void)xb_add(&bar[XB_XCNT(b.x)], 1u);
    return b;
}
__device__ __forceinline__ void xcd_barrier_complete(unsigned* bar, unsigned x, unsigned& nloc, unsigned& nx) {
    const unsigned G = gridDim.x * gridDim.y * gridDim.z;
    unsigned sum, cnt, mine, sp = 0u;
    for (;;) {
        sum = 0u; cnt = 0u; mine = 0u;
#pragma unroll
        for (unsigned j = 0; j < 16; ++j) { const unsigned c = xb_ld(&bar[XB_XCNT(j)]); sum += c; cnt += (c > 0u) ? 1u : 0u; mine = (j == x) ? c : mine; }
        if (sum == G) break;
        __builtin_amdgcn_s_sleep(1);
        if ((++sp & 255u) == 0u) { if (xb_ld(&bar[XB_TMO])) break; if (sp > XB_SPIN_CAP) { atomicAdd(&bar[XB_TMO], 1u); break; } }
    }
    nloc = mine > 0u ? mine : 1u; nx = cnt > 0u ? cnt : 1u;
}
__device__ __forceinline__ void xcd_barrier(const XcdBarrier& b) {
    asm volatile("s_waitcnt vmcnt(0)" ::: "memory");
    __syncthreads();
    if (threadIdx.x == 0) {
        unsigned* bar = b.bar;
        __builtin_amdgcn_s_waitcnt(0);
        unsigned nloc = b.st[0], nx = b.st[1];
        if (nloc == 0u) { xcd_barrier_complete(bar, b.x, nloc, nx); b.st[0] = nloc; b.st[1] = nx; }
        const unsigned old = xb_add(&bar[XB_XSUB(b.x)], 1u);
        const unsigned gen = old / nloc;
        if (old + 1u == (gen + 1u) * nloc) {
            __builtin_amdgcn_fence(__ATOMIC_RELEASE, "agent");
            asm volatile("s_waitcnt vmcnt(0)" ::: "memory");
            const unsigned og = xb_add(&bar[XB_TOP], 1u);
            const unsigned tg = og / nx;
            if (og + 1u == (tg + 1u) * nx) xb_add(&bar[XB_TOPGEN], 1u);
            else XB_SPIN(xb_ld(&bar[XB_TOPGEN]) == tg, bar);
            __builtin_amdgcn_fence(__ATOMIC_ACQUIRE, "agent");
            xb_add(&bar[XB_XGEN(b.x)], 1u);
            asm volatile("s_waitcnt vmcnt(0)" ::: "memory");
        } else {
            XB_SPIN(xb_ld(&bar[XB_XGEN(b.x)]) == gen, bar);
            __builtin_amdgcn_fence(__ATOMIC_ACQUIRE, "agent");
            asm volatile("s_waitcnt vmcnt(0)" ::: "memory");
        }
    }
    __syncthreads();
}

__global__ __launch_bounds__(512) void mega(Params p) {
    extern __shared__ __attribute__((aligned(16))) unsigned char shm[];
    cg::grid_group grid = cg::this_grid();
    LAS unsigned char* lds = (LAS unsigned char*)shm;
    unsigned char* ws = p.ws;
    const int G = gridDim.x, bid = blockIdx.x;
    const float* mod = (const float*)(ws + OFF_MOD);
    volatile LAS unsigned* bst = (volatile LAS unsigned*)(lds + LDS_STAGE);
    if (threadIdx.x < 2) bst[threadIdx.x] = 0u;
    __syncthreads();
    XcdBarrier xb; xb.bar = (unsigned*)(ws + OFF_BAR); xb.x = 0; xb.st = bst;
    for (int ph = p.ph_lo; ph < p.ph_hi; ++ph) {
      const int reps = (ph == REP_PH) ? 2 : 1;
      for (int rep = 0; rep < reps; ++rep) {
        const bool dry = rep + 1 < reps; (void)dry;
        if (rep) grid.sync();
        if (((STAGGER_MASK >> ph) & 1) && ((bid >> 3) & 1)) {
            const unsigned long long t0 = __builtin_amdgcn_s_memrealtime(); while (__builtin_amdgcn_s_memrealtime() - t0 < STAGGER_TICKS) __builtin_amdgcn_s_sleep(8); }
        if (PH_ON(0) && ph == 0) phase_prep(p, (float*)shm);
        else if (PH_ON(1) && ph == 1) phase_ln0(p);
        else if (PH_ON(3) && ph == 3 && bid >= 40) phase_postz(p);
        else if (PH_ON(2) && (ph == 2 || ph == 3)) {
            {
                pg8::Gemm gm{(const bf16_t*)(ws + OFF_H), (const bf16_t*)(ws + OFF_WI), NTOK, NWI, 2048, 2048, 2048};
                pg8::MixOrder S; S.so.init(64 * 256, NWI, G, bid); S.one = (ph == 3); S.remap = true; S.pm = 61 + (bid >> 3); S.pn = 12 + (bid & 7);
                pg8::EpiB<FZ> E{FZ{(bf16_t*)(ws + OFF_Z), (bf16_t*)(ws + OFF_SG0)}};
                pg8::gemm_phase(lds, gm, S, E);
            }
        }
        else if (PH_ON(4) && ph == 4) {
            { pg8::Gemm gm{(const bf16_t*)(ws + OFF_CQN), (const bf16_t*)(ws + OFF_WQ), NTOK, 1536, 768, 768, 768};
              pg8::StaticOrder S; S.init(gm.M, gm.N, G, bid);
              pg8::EpiB<FQa> E{FQa{(bf16_t*)(ws + OFF_QA)}};
              pg8::gemm_phase(lds, gm, S, E); }
            { pg8::Gemm gm{(const bf16_t*)(ws + OFF_CKVN), (const bf16_t*)(ws + OFF_WKV), NTOK, 2048, 512, 512, 512};
              pg8::StaticOrder S; S.init(gm.M, gm.N, G, (bid + G - 140) % G);
              pg8::EpiB<FKva> E{FKva{(bf16_t*)(ws + OFF_KA), (bf16_t*)(ws + OFF_VA)}};
              pg8::gemm_phase(lds, gm, S, E); }
            phase_fold(p, lds, 156);
        }
        else if (PH_ON(5) && ph == 5) {
            bf16_t* Y = (bf16_t*)(ws + OFF_SG0);
            for (int u = bid; u < 256; u += G) {
                const int qblk = u >> 3;
                const int nA = (u < 16) ? 3 : 2, nB = (u >= 16 && u < 32) ? 3 : 2;
                for (int it = 0; it < nA; ++it) {
                    const int b = it < 2 ? it : ((u >> 3) & 1), head = u & 7, seq = it < 2 ? LKV : CTX;
                    const size_t t0 = it < 2 ? (size_t)b * SEQ + qblk * 256 : (size_t)NLAT + b * CTX;
                    attn_body<64, 1, 1536>((const bf16_t*)(ws + OFF_QA) + t0 * 1536 + head * 192,
                                           (const bf16_t*)(ws + OFF_KA) + (size_t)(b * 8 + head) * LKV * 128, (const bf16_t*)(ws + OFF_VA) + (size_t)(b * 8 + head) * LKV * 128,
                                           (const bf16_t*)(ws + OFF_KPE) + (size_t)b * LKV * 64, Y + t0 * 2048 + head * 128, seq, (char*)shm, 0.07216878364870322f, dry);
                }
                for (int it = 0; it < nB; ++it) {
                    const int b = it < 2 ? it : ((u >> 3) & 1), head = u & 7, kvh = head >> 2, seq = it < 2 ? LKV : CTX;
                    const size_t t0 = it < 2 ? (size_t)b * SEQ + qblk * 256 : (size_t)NLAT + b * CTX;
                    attn_body<0, 2, 1024>((const bf16_t*)(ws + OFF_QB) + t0 * 1024 + head * 128,
                                          (const bf16_t*)(ws + OFF_KB) + (size_t)(b * 2 + kvh) * LKV * 128, (const bf16_t*)(ws + OFF_VB) + (size_t)(b * 2 + kvh) * LKV * 128,
                                          nullptr, Y + t0 * 2048 + 1024 + head * 128, seq, (char*)shm, 0.08838834764831845f, dry);
                }
            }
        }
        else if (PH_ON(6) && (ph == 6 || ph == 7)) {
            if (ph == 6 || bid < 16) {
                pg8::Gemm gm{(const bf16_t*)(ws + OFF_SG0), (const bf16_t*)(ws + OFF_WO), NLAT, 2048, 2048, 2048, 2048};
                pg8::MixOrder S; S.so.init(gm.M, gm.N, G, bid); S.one = (ph == 7); S.remap = false; S.pm = 64 + (bid >> 3); S.pn = bid & 7;
                pg8::EpiB<FDelta> E{FDelta{mod + 4096, ph == 6 ? (bf16_t*)p.out + 2048 : (bf16_t*)(ws + OFF_DC) - (size_t)NLAT * DM, ph == 6 ? 4096 : 2048}};
                pg8::gemm_phase(lds, gm, S, E);
            } else phase_ln1(p);
        }
        else if (PH_ON(8) && ph == 8) {
            phase_xc(p);
            { pg8::Gemm gm{(const bf16_t*)(ws + OFF_WFU), (const bf16_t*)(ws + OFF_H1), 4096, NLAT, 2048, 2048, 2048};
              pg8::StaticOrder S; S.init(gm.M, gm.N, G, bid);
              pg8::EpiB<FStore> E{FStore{(bf16_t*)(ws + OFF_PT), NLAT}};
              pg8::gemm_phase(lds, gm, S, E); }
        }
        else if (PH_ON(9) && ph == 9) phase_radix16(p);
        else if (PH_ON(10) && ph == 10) {
            pg8::Gemm gm{(const bf16_t*)(ws + OFF_TRIG), (const bf16_t*)(ws + OFF_ZS), 512, NZS, 1024, 1024, 1024};
            pg8::StaticOrder S; S.init(gm.M, gm.N, G, bid);
            pg8::EpiB<FXr> E{FXr{(bf16_t*)(ws + OFF_XR), (bf16_t*)(ws + OFF_XR128)}};
            pg8::gemm_phase(lds, gm, S, E);
        }
        else if (PH_ON(11) && ph == 11) {
            pg8::Gemm gm{(const bf16_t*)(ws + OFF_H1), (const bf16_t*)(ws + OFF_WFG), NLAT, 4096, 2048, 2048, 2048};
            pg8::StaticOrder S; S.init(gm.M, gm.N, G, bid);
            pg8::EpiB<FGate> E{FGate{(const bf16_t*)(ws + OFF_XR), (const bf16_t*)(ws + OFF_XR128), (bf16_t*)(ws + OFF_SG)}};
            pg8::gemm_phase(lds, gm, S, E);
        }
        else if (PH_ON(12) && ph == 12) {
            pg8::Gemm gm{(const bf16_t*)(ws + OFF_SG), (const bf16_t*)(ws + OFF_WOF), NLAT, 2048, 4096, 4096, 4096};
            pg8::StaticOrder S; S.init(gm.M, gm.N, G, bid);
            pg8::EpiB<FDelta> E{FDelta{mod + 3 * 6144 + 4096, (bf16_t*)(ws + OFF_D2), 2048}};
            pg8::gemm_phase(lds, gm, S, E);
        }
        else if (PH_ON(13) && ph == 13) phase_ln2(p);
      }
        if (ph + 1 < p.ph_hi) {
            if (ph == 0) { grid.sync(); xb = xcd_barrier_post((unsigned*)(ws + OFF_BAR), bst); }
            else xcd_barrier(xb); }
    }
}

extern "C" void kernel_launch(void* const* d_in, const int* in_sizes, int n_in, void* d_out, int out_size, void* d_ws, size_t ws_size, hipStream_t stream) {
    static int grid = 0;
    if (grid == 0) {
        if (n_in != 18 || in_sizes[0] != NLAT * DM || out_size != NLAT * DM || ws_size < WS_NEED) {
            fprintf(stderr, "kernel_launch: shape/workspace mismatch (n_in %d, in0 %d, out %d, ws %zu, need %zu)\n", n_in, n_in > 0 ? in_sizes[0] : -1, out_size, ws_size, (size_t)WS_NEED); grid = -1; return; }
        int dev = 0, cus = 0, per_cu = 0;
        (void)hipGetDevice(&dev); (void)hipDeviceGetAttribute(&cus, hipDeviceAttributeMultiprocessorCount, dev);
        if (hipFuncSetAttribute((const void*)mega, hipFuncAttributeMaxDynamicSharedMemorySize, LDS_BYTES) != hipSuccess) { fprintf(stderr, "kernel_launch: hipFuncSetAttribute failed\n"); grid = -1; return; }
        if (hipOccupancyMaxActiveBlocksPerMultiprocessor(&per_cu, (const void*)mega, 512, LDS_BYTES) != hipSuccess || per_cu < 1) { fprintf(stderr, "kernel_launch: occupancy query says %d\n", per_cu); per_cu = 1; }
        (void)hipGetLastError();
        grid = cus * 1;
        if (grid > 256) grid = 256;
    }
    if (grid < 0) return;
    Params p{};
    p.x = (const float*)d_in[0]; p.c = (const float*)d_in[1]; p.ctx = (const float*)d_in[2]; p.c_ctx = (const float*)d_in[3]; p.ada_w = (const float*)d_in[4]; p.ada_b = (const float*)d_in[5];
    p.ln_g = (const float*)d_in[6]; p.ln_b = (const float*)d_in[7]; p.w_in_attn = (const float*)d_in[8]; p.wq_b = (const float*)d_in[9]; p.q_lora_g = (const float*)d_in[10];
    p.kv_lora_g = (const float*)d_in[11]; p.wkv_b = (const float*)d_in[12]; p.qn_g = (const float*)d_in[13]; p.kn_g = (const float*)d_in[14]; p.w_out_attn = (const float*)d_in[15];
    p.w_in_f = (const float*)d_in[16]; p.w_out_f = (const float*)d_in[17]; p.out = (float*)d_out; p.ws = (unsigned char*)d_ws;
#if MK_MULTI
    for (int ph = 0; ph < NPH; ++ph) { p.ph_lo = ph; p.ph_hi = ph + 1; hipLaunchKernelGGL(mega, dim3(grid), dim3(512), LDS_BYTES, stream, p); }
#else
    p.ph_lo = 0; p.ph_hi = NPH;
    void* args[] = {&p};
    hipError_t e = hipLaunchCooperativeKernel((const void*)mega, dim3(grid), dim3(512), args, LDS_BYTES, stream);
    if (e != hipSuccess) fprintf(stderr, "kernel_launch: cooperative launch failed: %s (grid %d)\n", hipGetErrorString(e), grid);
#endif
}
```

```cpp
#include <hip/hip_runtime.h>
#include <hip/hip_cooperative_groups.h>
#include <cstdio>
#include <cstdint>
namespace cg = cooperative_groups;

#ifndef MK_MULTI
#define MK_MULTI 0
#endif
#ifndef PHMASK
#define PHMASK 0xffff
#endif
#define PH_ON(n) ((PHMASK >> (n)) & 1)
#ifndef STAGGER_TICKS
#define STAGGER_TICKS 2200ull
#endif
#ifndef STAGGER_MASK
#define STAGGER_MASK 0x0
#endif
#ifndef REP_PH
#define REP_PH -1
#endif

typedef unsigned short bf16_t;
typedef short bf16x8 __attribute__((ext_vector_type(8)));
typedef short s16x4 __attribute__((ext_vector_type(4)));
typedef float f32x4 __attribute__((ext_vector_type(4)));
typedef float f32x16 __attribute__((ext_vector_type(16)));
typedef unsigned u32x4 __attribute__((ext_vector_type(4)));
typedef unsigned u32x2 __attribute__((ext_vector_type(2)));
#define LAS __attribute__((address_space(3)))

constexpr int DM = 2048, NB = 2, SEQ = 8192, CTX = 256, NLAT = NB * SEQ, NTOK = NLAT + NB * CTX, LKV = SEQ + CTX;
constexpr int ZW = 3072;
constexpr int NWI = 5120;
constexpr float ALPHA = 1.4142135623730951f;
constexpr int LDH = 2048 + 64;
constexpr int NPH = 14;
constexpr int LDS_STAGE = 131072;
constexpr int LDS_BYTES = LDS_STAGE + 256;

constexpr size_t al256(size_t x) { return (x + 255) / 256 * 256; }
constexpr size_t OFF_WI = 0;
constexpr size_t OFF_WQ = OFF_WI + (size_t)NWI * LDH * 2;
constexpr size_t OFF_WKV = OFF_WQ + (size_t)1536 * 768 * 2;
constexpr size_t OFF_WO = OFF_WKV + (size_t)2048 * 512 * 2;
constexpr size_t OFF_WFU = OFF_WO + (size_t)2048 * 2048 * 2;
constexpr size_t OFF_WFG = OFF_WFU + (size_t)4096 * 2048 * 2;
constexpr size_t OFF_WOF = OFF_WFG + (size_t)4096 * 2048 * 2;
constexpr size_t OFF_WUB = OFF_WOF + (size_t)2048 * 4096 * 2;
constexpr size_t OFF_TT = OFF_WUB + (size_t)2048 * 4096 * 2;
constexpr size_t OFF_TRIG = OFF_TT + (size_t)256 * 256 * 2;
constexpr size_t OFF_MOD = OFF_TRIG + (size_t)1024 * 2048 * 2;
constexpr size_t OFF_BAR = al256(OFF_MOD + (size_t)2 * 3 * 6144 * 4);
constexpr size_t OFF_L = al256(OFF_BAR + (size_t)3456 * 4);
constexpr size_t OFF_H = OFF_L;
constexpr size_t OFF_CQN = OFF_H;
constexpr size_t OFF_CKVN = OFF_CQN + (size_t)NTOK * 768 * 2;
constexpr size_t OFF_Z = OFF_H + (size_t)NTOK * LDH * 2;
constexpr size_t OFF_SG0 = OFF_Z + (size_t)NTOK * ZW * 2;
constexpr size_t OFF_QB = OFF_SG0 + (size_t)NTOK * 2048 * 2;
constexpr size_t OFF_KB = OFF_QB + (size_t)NTOK * 1024 * 2;
constexpr size_t OFF_VB = OFF_KB + (size_t)NB * 2 * LKV * 128 * 2;
constexpr size_t OFF_KPE = OFF_VB + (size_t)NB * 2 * LKV * 128 * 2;
constexpr size_t OFF_QA = OFF_KPE + (size_t)NB * LKV * 64 * 2;
constexpr size_t OFF_KA = OFF_QA + (size_t)NTOK * 1536 * 2;
constexpr size_t OFF_VA = OFF_KA + (size_t)NB * 8 * LKV * 128 * 2;
constexpr size_t OFF_DC = OFF_WI + (size_t)NB * CTX * DM * 4;
constexpr size_t OFF_XC = OFF_WI;
constexpr size_t OFF_D0 = OFF_Z;
constexpr size_t END0 = OFF_VA + (size_t)NB * 8 * LKV * 128 * 2;
constexpr int NZS = 66048;
constexpr size_t OFF_ZS = OFF_L;
constexpr size_t OFF_SG = OFF_ZS;
constexpr size_t OFF_PT = OFF_ZS + (size_t)NZS * 1024 * 2;
constexpr size_t OFF_XR = OFF_PT;
constexpr size_t OFF_XR128 = OFF_XR + (size_t)NLAT * 2048 * 2;
constexpr size_t OFF_H1 = OFF_PT + (size_t)4096 * NLAT * 2;
constexpr size_t OFF_D2 = OFF_H1 + (size_t)NLAT * 2048 * 2;
constexpr size_t END1 = OFF_D2 + (size_t)NLAT * 2048 * 2;
constexpr size_t WS_NEED = END0 > END1 ? END0 : END1;

struct Params {
    const float *x, *c, *ctx, *c_ctx, *ada_w, *ada_b, *ln_g, *ln_b, *w_in_attn, *wq_b, *q_lora_g, *kv_lora_g, *wkv_b, *qn_g, *kn_g, *w_out_attn, *w_in_f, *w_out_f;
    float* out; unsigned char* ws; int ph_lo, ph_hi;
};

__device__ __forceinline__ unsigned cvtpk(float lo, float hi) { unsigned r; asm("v_cvt_pk_bf16_f32 %0, %1, %2" : "=v"(r) : "v"(lo), "v"(hi)); return r; }
__device__ __forceinline__ int tid_l() { int t = threadIdx.x; asm volatile("" : "+v"(t)); return t; }
__device__ __forceinline__ int bid_l() { int t = blockIdx.x; asm volatile("" : "+s"(t)); return t; }
__device__ __forceinline__ float bflo(unsigned w) { return __uint_as_float(w << 16); }
__device__ __forceinline__ float bfhi(unsigned w) { return __uint_as_float(w & 0xffff0000u); }
__device__ __forceinline__ float bf2f(bf16_t b) { return __uint_as_float(((unsigned)b) << 16); }
__device__ __forceinline__ bf16_t f2bf(float f) { return (bf16_t)(cvtpk(f, 0.f) & 0xffffu); }
template <int O> __device__ __forceinline__ float xor_swz(float v) {
    return __int_as_float(__builtin_amdgcn_ds_swizzle(__float_as_int(v), 0x1F | (O << 10))); }
__device__ __forceinline__ float xor32(float v) {
    auto rr = __builtin_amdgcn_permlane32_swap(__float_as_uint(v), __float_as_uint(v), false, false);
    const float a = __uint_as_float(rr[0]), b = __uint_as_float(rr[1]);
    return (a == v) ? b : a;
}
__device__ __forceinline__ float sum16(float v) { v += xor_swz<8>(v); v += xor_swz<4>(v); v += xor_swz<2>(v); v += xor_swz<1>(v); return v; }
__device__ __forceinline__ float wave_sum(float v) {
    v += xor_swz<16>(v); v = sum16(v);
    auto rr = __builtin_amdgcn_permlane32_swap(__float_as_uint(v), __float_as_uint(v), false, false);
    return __uint_as_float(rr[0]) + __uint_as_float(rr[1]);
}
__device__ __forceinline__ float silu(float x) { return x / (1.f + __expf(-x)); }
__device__ __forceinline__ void unpack8(u32x4 w, float (&v)[8]) {
    v[0] = bflo(w.x); v[1] = bfhi(w.x); v[2] = bflo(w.y); v[3] = bfhi(w.y); v[4] = bflo(w.z); v[5] = bfhi(w.z); v[6] = bflo(w.w); v[7] = bfhi(w.w);
}
__device__ __forceinline__ u32x4 pack8(const float (&v)[8]) { u32x4 w; w.x = cvtpk(v[0], v[1]); w.y = cvtpk(v[2], v[3]); w.z = cvtpk(v[4], v[5]); w.w = cvtpk(v[6], v[7]); return w; }
__device__ __forceinline__ float cos_rev(float r) { return __builtin_amdgcn_cosf(r); }
__device__ __forceinline__ float sin_rev(float r) { return __builtin_amdgcn_sinf(r); }
__device__ __forceinline__ void rope8(float (&v)[8], int i0, int nhalf, float prow, float pcol) {
#pragma unroll
    for (int j = 0; j < 4; ++j) {
        const int i = i0 + j; const int fi = i < nhalf ? i : i - nhalf; const float pos = i < nhalf ? prow : pcol;
        const float inv = __builtin_amdgcn_exp2f(-(float)fi * (13.287712379549449f / (float)nhalf));
        const float rev = pos * inv * 0.15915494309189535f;
        const float cs = cos_rev(rev), sn = sin_rev(rev), a = v[2 * j], b = v[2 * j + 1];
        v[2 * j] = a * cs - b * sn; v[2 * j + 1] = a * sn + b * cs;
    }
}

namespace pg8 {
constexpr int BM = 256, BK = 64, HALF = 128, HTB = HALF * BK * 2, NXCD = 8, WGM = 3;
__device__ __forceinline__ int lds_byte(int r, int c) { const int st = (r >> 4) * 2 + (c >> 5), rr = r & 15, cc = c & 31, ob = rr * 64 + cc * 2; return st * 1024 + (ob ^ (((ob >> 9) & 1) << 5)); }
__device__ __forceinline__ void stage_rc(int b, int& R, int& C) { const int st = b / 1024, sb = b % 1024, swz = sb ^ (((sb >> 9) & 1) << 5); R = (st >> 1) * 16 + swz / 64; C = (st & 1) * 32 + (swz % 64) / 2; }
__device__ __forceinline__ int perm32(int rho) { const int n = rho >> 4, i = rho & 15; return 8 * (i >> 2) + 4 * n + (i & 3); }
struct Unit { int pm, pn; };
struct Gemm { const bf16_t* A; const bf16_t* Bt; int M, N, K, lda, ldb; };
struct StaticOrder {
    int nM, nN, nwg, G, c;
    __device__ void init(int M, int N, int G_, int c_) { nM = M / BM; nN = N / BM; nwg = nM * nN; G = G_; c = c_; }
    __device__ bool next(int i, Unit& u) const {
        const long L = (long)i * G + c; if (L >= nwg) return false;
        int wgid = (int)L; { const int q = nwg / NXCD, r = nwg % NXCD, xcd = wgid % NXCD, off = wgid / NXCD; wgid = (xcd < r ? xcd * (q + 1) : r * (q + 1) + (xcd - r) * q) + off; }
        const int nig = WGM * nN, gid = wgid / nig, fm = gid * WGM, gsz = (nM - fm) < WGM ? (nM - fm) : WGM;
        u.pm = fm + ((wgid % nig) % gsz); u.pn = (wgid % nig) / gsz; return true;
    }
};
struct MixOrder { StaticOrder so; int pm, pn; bool one, remap;
    __device__ bool next(int i, Unit& u) const {
        if (!one) { if (!so.next(i, u)) return false; if (remap && u.pm >= 61) { const int q = (u.pm - 61) * 20 + u.pn; u.pm = 61 + q / 12; u.pn = q % 12; } return true; }
        if (i) return false; u.pm = pm; u.pn = pn; return true; } };
struct OneUnit { int pm, pn; __device__ bool next(int i, Unit& u) const { if (i) return false; u.pm = pm; u.pn = pn; return true; } };

template <class Epi, class Sched>
__device__ __forceinline__ void gemm_phase(LAS unsigned char* lds, const Gemm g, const Sched& S, const Epi& E) {
    const int tid = tid_l(), wid = __builtin_amdgcn_readfirstlane(tid >> 6), lane = tid & 63, wr = wid >> 2, wc = wid & 3, fr = lane & 15, fq = lane >> 4;
    const int K = g.K, nt = K / BK;
    unsigned voffA[2], voffB[2];
#pragma unroll
    for (int i = 0; i < 2; ++i) { int R, C; stage_rc(tid * 16 + i * 8192, R, C); const int Rb = Epi::PERM ? ((R & ~31) + perm32(R & 31)) : R;
        voffA[i] = (unsigned)(R * g.lda + C) * 2u; voffB[i] = (unsigned)(Rb * g.ldb + C) * 2u; }
    const size_t kstep = (size_t)(BK * 2);
    const size_t hsA = (size_t)HALF * g.lda * 2, hsB = (size_t)HALF * g.ldb * 2;
    const size_t tsA = 2 * hsA, tsB = 2 * hsB;
    const unsigned ldsw = (unsigned)wid * 1024u;
    const int aoff = lds_byte(wr * 64 + fr, fq * 8), boff = lds_byte(wc * 32 + fr, fq * 8);
#define PG8_SA(b, h) (((b) * 2 + (h)) * HTB)
#define PG8_SB(b, h) ((4 + (b) * 2 + (h)) * HTB)
#define PG8_STAGE(bufoff, gbase, voff) do { _Pragma("unroll") for (int _i = 0; _i < 2; ++_i) \
        __builtin_amdgcn_global_load_lds((const unsigned*)((const char*)(gbase) + (voff)[_i]), (LAS unsigned*)(lds + (bufoff) + ldsw + _i * 8192), 16, 0, 0); } while (0)
#define PG8_LDA(dst, b, h) do { _Pragma("unroll") for (int m = 0; m < 4; ++m) _Pragma("unroll") for (int k = 0; k < 2; ++k) dst[m][k] = *(const LAS bf16x8*)(lds + PG8_SA(b, h) + aoff + m * 2048 + k * 1024); } while (0)
#define PG8_LDB(dst, b, h) do { _Pragma("unroll") for (int n = 0; n < 2; ++n) _Pragma("unroll") for (int k = 0; k < 2; ++k) dst[n][k] = *(const LAS bf16x8*)(lds + PG8_SB(b, h) + boff + n * 2048 + k * 1024); } while (0)
#define PG8_MMA(ai, bj, At, Bt) do { __builtin_amdgcn_s_setprio(1); _Pragma("unroll") for (int m = 0; m < 4; ++m) _Pragma("unroll") for (int n = 0; n < 2; ++n) _Pragma("unroll") for (int k = 0; k < 2; ++k) \
        acc[ai][bj][m][n] = __builtin_amdgcn_mfma_f32_16x16x32_bf16(Bt[n][k], At[m][k], acc[ai][bj][m][n], 0, 0, 0); __builtin_amdgcn_s_setprio(0); } while (0)
#define PG8_WAIT_V(n) asm volatile("s_waitcnt vmcnt(" #n ")" ::: "memory")
#define PG8_WAIT_L(n) asm volatile("s_waitcnt lgkmcnt(" #n ")" ::: "memory")
#define PG8_BAR __builtin_amdgcn_s_barrier()
#define PG8_SCHED __builtin_amdgcn_sched_barrier(0)
    Unit cur, nxt; int ui = 0;
    if (!S.next(0, cur)) return;
    f32x4 acc[2][2][4][2];
#pragma unroll
    for (int a = 0; a < 2; ++a)
#pragma unroll
        for (int b = 0; b < 2; ++b)
#pragma unroll
            for (int m = 0; m < 4; ++m)
#pragma unroll
                for (int n = 0; n < 2; ++n) acc[a][b][m][n] = (f32x4){0.f, 0.f, 0.f, 0.f};
    bf16x8 At[4][2], B0[2][2], B1[2][2];
    const char* cA = (const char*)g.A + (size_t)cur.pm * tsA; const char* cB = (const char*)g.Bt + (size_t)cur.pn * tsB;
    PG8_STAGE(PG8_SB(0, 0), cB, voffB); PG8_STAGE(PG8_SA(0, 0), cA, voffA); PG8_STAGE(PG8_SB(0, 1), cB + hsB, voffB); PG8_STAGE(PG8_SA(0, 1), cA + hsA, voffA);
    if (wr == 1) PG8_BAR;
    PG8_WAIT_V(4); PG8_BAR;
    PG8_STAGE(PG8_SB(1, 0), cB + kstep, voffB); PG8_STAGE(PG8_SA(1, 0), cA + kstep, voffA); PG8_STAGE(PG8_SB(1, 1), cB + hsB + kstep, voffB);
    PG8_WAIT_V(6); PG8_BAR;
    for (;;) {
        const bool has_next = S.next(ui + 1, nxt);
        const char* nA = has_next ? (const char*)g.A + (size_t)nxt.pm * tsA : cA; const char* nB = has_next ? (const char*)g.Bt + (size_t)nxt.pn * tsB : cB;
        for (int t = 0; t < nt; t += 2) {
            const bool last = (t == nt - 2);
            const char* a1 = cA + (size_t)(t + 1) * kstep;
            const char* a2 = last ? nA : cA + (size_t)(t + 2) * kstep; const char* b2 = last ? nB : cB + (size_t)(t + 2) * kstep;
            const char* a3 = a2 + kstep; const char* b3 = b2 + kstep;
            PG8_LDB(B0, 0, 0); PG8_SCHED; PG8_LDA(At, 0, 0); PG8_STAGE(PG8_SA(1, 1), a1 + hsA, voffA);
            PG8_WAIT_L(8); PG8_BAR; PG8_WAIT_L(0); PG8_MMA(0, 0, At, B0); PG8_BAR; PG8_SCHED;
            PG8_LDB(B1, 0, 1); PG8_STAGE(PG8_SB(0, 0), b2, voffB);
            PG8_BAR; PG8_WAIT_L(0); PG8_MMA(0, 1, At, B1); PG8_BAR;
            PG8_LDA(At, 0, 1); PG8_STAGE(PG8_SA(0, 0), a2, voffA);
            PG8_BAR; PG8_WAIT_L(0); PG8_MMA(1, 0, At, B0); PG8_BAR; PG8_SCHED;
            PG8_STAGE(PG8_SB(0, 1), b2 + hsB, voffB);
            PG8_WAIT_V(6); PG8_BAR; PG8_MMA(1, 1, At, B1); PG8_BAR;
            PG8_LDB(B0, 1, 0); PG8_SCHED; PG8_LDA(At, 1, 0); PG8_STAGE(PG8_SA(0, 1), a2 + hsA, voffA);
            PG8_WAIT_L(8); PG8_BAR; PG8_WAIT_L(0); PG8_MMA(0, 0, At, B0); PG8_BAR; PG8_SCHED;
            PG8_LDB(B1, 1, 1); PG8_STAGE(PG8_SB(1, 0), b3, voffB);
            PG8_BAR; PG8_WAIT_L(0); PG8_MMA(0, 1, At, B1); PG8_BAR;
            PG8_LDA(At, 1, 1); PG8_STAGE(PG8_SA(1, 0), a3, voffA);
            PG8_BAR; PG8_WAIT_L(0); PG8_MMA(1, 0, At, B0); PG8_BAR; PG8_SCHED;
            PG8_STAGE(PG8_SB(1, 1), b3 + hsB, voffB);
            PG8_WAIT_V(6); PG8_BAR; PG8_MMA(1, 1, At, B1); PG8_BAR;
        }
        E(acc, cur, wr, wc, fr, fq);
        if (!has_next) break;
#pragma unroll
        for (int a = 0; a < 2; ++a)
#pragma unroll
            for (int b = 0; b < 2; ++b)
#pragma unroll
                for (int m = 0; m < 4; ++m)
#pragma unroll
                    for (int n = 0; n < 2; ++n) acc[a][b][m][n] = (f32x4){0.f, 0.f, 0.f, 0.f};
        cur = nxt; cA = nA; cB = nB; ++ui;
    }
    PG8_WAIT_V(0);
    if (wr == 0) PG8_BAR;
    PG8_BAR;
#undef PG8_SA
#undef PG8_SB
#undef PG8_STAGE
#undef PG8_LDA
#undef PG8_LDB
#undef PG8_MMA
#undef PG8_WAIT_V
#undef PG8_WAIT_L
#undef PG8_BAR
#undef PG8_SCHED
}
template <class F> struct EpiB { static constexpr bool PERM = true; F f;
    __device__ __forceinline__ void operator()(const f32x4 (&acc)[2][2][4][2], const Unit& u, int wr, int wc, int fr, int fq) const {
#pragma unroll
        for (int ai = 0; ai < 2; ++ai)
#pragma unroll
            for (int m = 0; m < 4; ++m)
#pragma unroll
                for (int bj = 0; bj < 2; ++bj) {
                    const int row = u.pm * BM + ai * HALF + wr * 64 + m * 16 + fr, col = u.pn * BM + bj * HALF + wc * 32 + 8 * fq;
                    float v[8] = {acc[ai][bj][m][0][0], acc[ai][bj][m][0][1], acc[ai][bj][m][0][2], acc[ai][bj][m][0][3], acc[ai][bj][m][1][0], acc[ai][bj][m][1][1], acc[ai][bj][m][1][2], acc[ai][bj][m][1][3]};
                    f(row, col, v); }
    } };
template <class F> struct EpiF { static constexpr bool PERM = false; F f;
    __device__ __forceinline__ void operator()(const f32x4 (&acc)[2][2][4][2], const Unit& u, int wr, int wc, int fr, int fq) const {
#pragma unroll
        for (int ai = 0; ai < 2; ++ai)
#pragma unroll
            for (int m = 0; m < 4; ++m)
#pragma unroll
                for (int bj = 0; bj < 2; ++bj)
#pragma unroll
                    for (int n = 0; n < 2; ++n) {
                        const int row = u.pm * BM + ai * HALF + wr * 64 + m * 16 + fr, col = u.pn * BM + bj * HALF + wc * 32 + 16 * n + 4 * fq;
                        f(row, col, acc[ai][bj][m][n]); }
    } };
}

struct FStore { bf16_t* O; int ldc;
    __device__ __forceinline__ void operator()(int row, int col, float (&v)[8]) const { *(u32x4*)(O + (size_t)row * ldc + col) = pack8(v); } };
struct FSilu { bf16_t* O; int ldc;
    __device__ __forceinline__ void operator()(int row, int col, float (&v)[8]) const {
#pragma unroll
        for (int j = 0; j < 8; ++j) v[j] = silu(v[j]);
        *(u32x4*)(O + (size_t)row * ldc + col) = pack8(v); } };
struct FGate { const bf16_t* XR; const bf16_t* XR128; bf16_t* Y;
    __device__ __forceinline__ void operator()(int row, int col, float (&v)[8]) const {
        constexpr float NRM = 0.011048543456039806f;
        const int g = col >> 8, k20 = col & 255, b = row >> 13, k1 = row & (SEQ - 1);
        float f[8];
        if (k20 < 128) unpack8(*(const u32x4*)(XR + (size_t)row * 2048 + g * 128 + k20), f);
        else {
            const bf16_t* xm = XR + (size_t)(b * SEQ + ((SEQ - k1) & (SEQ - 1))) * 2048 + g * 128;
            float lo[8]; unpack8(*(const u32x4*)(xm + 248 - k20), lo);
#pragma unroll
            for (int j = 1; j < 8; ++j) f[j] = lo[8 - j];
            f[0] = (k20 == 128) ? bf2f(XR128[(size_t)row * 16 + g]) : bf2f(xm[256 - k20]);
        }
#pragma unroll
        for (int j = 0; j < 8; ++j) v[j] = silu(v[j]) * NRM * f[j];
        *(u32x4*)(Y + (size_t)row * 4096 + col) = pack8(v); } };
struct FZ { bf16_t* Z; bf16_t* SG0;
    __device__ __forceinline__ void operator()(int row, int col, float (&v)[8]) const {
        if (col < ZW) { *(u32x4*)(Z + (size_t)row * ZW + col) = pack8(v); }
        else {
#pragma unroll
            for (int j = 0; j < 8; ++j) v[j] = silu(v[j]);
            *(u32x4*)(SG0 + (size_t)row * 2048 + (col - ZW)) = pack8(v); } } };
struct FQa { bf16_t* Qa;
    __device__ __forceinline__ void operator()(int row, int col, float (&v)[8]) const {
        const int d = col % 192;
        if (d >= 128 && row < NLAT) { const int s = row & (SEQ - 1); rope8(v, (d - 128) >> 1, 16, (float)(s >> 6), (float)(s & 63)); }
        *(u32x4*)(Qa + (size_t)row * 1536 + col) = pack8(v); } };
struct FKva { bf16_t* Ka; bf16_t* Va;
    __device__ __forceinline__ void operator()(int row, int col, float (&v)[8]) const {
        const int head = col >> 8, dd = col & 255, d = dd & 127; int b, pos;
        if (row < NLAT) { b = row >> 13; pos = CTX + (row & (SEQ - 1)); } else { const int cr = row - NLAT; b = cr >> 8; pos = cr & 255; }
        bf16_t* dst = (dd >= 128 ? Va : Ka) + ((size_t)((b * 8 + head) * LKV + pos) * 128 + d);
        *(u32x4*)dst = pack8(v); } };
struct FRes { const float* xin; const float* gate; float* out;
    __device__ __forceinline__ void operator()(int row, int col, const f32x4& a) const {
        const int b = row >> 13; const size_t idx = (size_t)row * DM + col;
        const f32x4 xv = *(const f32x4*)(xin + idx), gv = *(const f32x4*)(gate + b * 6144 + col);
        *(f32x4*)(out + idx) = xv * ALPHA + gv * a; } };
struct FDelta { const float* gate; bf16_t* D; int ldd;
    __device__ __forceinline__ void operator()(int row, int col, float (&v)[8]) const {
        const int b = row < NLAT ? (row >> 13) : 2; const f32x4 g0 = *(const f32x4*)(gate + b * 6144 + col), g1 = *(const f32x4*)(gate + b * 6144 + col + 4);
        v[0] *= g0[0]; v[1] *= g0[1]; v[2] *= g0[2]; v[3] *= g0[3]; v[4] *= g1[0]; v[5] *= g1[1]; v[6] *= g1[2]; v[7] *= g1[3];
        *(u32x4*)(D + (size_t)row * ldd + col) = pack8(v); } };
struct FXr { bf16_t* XR; bf16_t* XR128;
    __device__ __forceinline__ void operator()(int row, int col, float (&v)[8]) const {
        if (col < 65536) { const int k2 = col & 127, s = (col >> 7) & 15, bg = col >> 11, b = bg >> 4, g = bg & 15;
            *(u32x4*)(XR + (size_t)(b * SEQ + 16 * row + s) * 2048 + g * 128 + k2) = pack8(v); }
        else { const int c = col - 65536, bg = c >> 4, s0 = c & 15, b = bg >> 4, g = bg & 15;
#pragma unroll
            for (int j = 0; j < 8; ++j) XR128[(size_t)(b * SEQ + 16 * row + s0 + j) * 16 + g] = f2bf(v[j]); } } };

#define KSWZ(row, colB) ((row) * 256 + ((colB) ^ (((row) & 7) << 4)))
#define XSWZ(row, colB) ((row) * 128 + ((colB) ^ (((row) & 7) << 4)))
#define SBAR() __builtin_amdgcn_sched_barrier(0)
constexpr int A_SHM_V = 64 * 128 * 2, A_SHM_K = 64 * 128 * 2, A_SHM_X = 64 * 64 * 2;
__device__ __forceinline__ unsigned cvtpk_v(float lo, float hi) { unsigned r; asm volatile("v_cvt_pk_bf16_f32 %0, %1, %2" : "=v"(r) : "v"(lo), "v"(hi)); return r; }
__device__ __forceinline__ int crow(int r, int hi) { return (r & 3) + 8 * (r >> 2) + 4 * hi; }
__device__ __forceinline__ void partialSM(f32x16& p0, f32x16& p1, float& m_reg, float& mn, float& alpha, const float SCALE) {
    const float C = SCALE * 1.4426950408889634f; const float THRS = 8.f / SCALE;
    float pmax = p0[0];
#pragma unroll
    for (int r = 1; r < 16; ++r) pmax = fmaxf(pmax, p0[r]);
#pragma unroll
    for (int r = 0; r < 16; ++r) pmax = fmaxf(pmax, p1[r]);
    { auto rr = __builtin_amdgcn_permlane32_swap(__float_as_uint(pmax), __float_as_uint(pmax), false, false);
      pmax = fmaxf(__uint_as_float(rr[0]), __uint_as_float(rr[1])); }
    if (__builtin_expect(__all(pmax - m_reg <= THRS), 1)) { mn = m_reg; alpha = 1.f; }
    else { mn = fmaxf(m_reg, pmax); alpha = __builtin_amdgcn_exp2f((m_reg - mn) * C); m_reg = mn; }
    const float mnC = -mn * C;
#pragma unroll
    for (int r = 0; r < 16; ++r) p0[r] = fmaf(p0[r], C, mnC);
#pragma unroll
    for (int r = 0; r < 16; ++r) p1[r] = fmaf(p1[r], C, mnC);
#pragma unroll
    for (int r = 0; r < 16; ++r) p0[r] = __builtin_amdgcn_exp2f(p0[r]);
}
__device__ __forceinline__ void finishSM(f32x16& p0, f32x16& p1, float alpha, float& l_reg, bf16x8& pa0, bf16x8& pa1, bf16x8& pa2, bf16x8& pa3) {
#pragma unroll
    for (int r = 0; r < 16; ++r) p1[r] = __builtin_amdgcn_exp2f(p1[r]);
    float ps = 0;
#pragma unroll
    for (int r = 0; r < 16; ++r) ps += p0[r];
#pragma unroll
    for (int r = 0; r < 16; ++r) ps += p1[r];
    { auto rr = __builtin_amdgcn_permlane32_swap(__float_as_uint(ps), __float_as_uint(ps), false, false);
      ps = __uint_as_float(rr[0]) + __uint_as_float(rr[1]); }
    l_reg = l_reg * alpha + ps;
#define PK4(P, BASE, OUT) do { unsigned a0 = cvtpk_v(P[BASE + 0], P[BASE + 1]), a1 = cvtpk_v(P[BASE + 2], P[BASE + 3]);   \
    unsigned b0 = cvtpk_v(P[BASE + 4], P[BASE + 5]), b1 = cvtpk_v(P[BASE + 6], P[BASE + 7]);                              \
    auto r0 = __builtin_amdgcn_permlane32_swap(a0, b0, false, false); auto r1 = __builtin_amdgcn_permlane32_swap(a1, b1, false, false); \
    u32x4 w = {r0[0], r1[0], r0[1], r1[1]}; OUT = *reinterpret_cast<bf16x8*>(&w); } while (0)
    PK4(p0, 0, pa0); PK4(p0, 8, pa1); PK4(p1, 0, pa2); PK4(p1, 8, pa3);
#undef PK4
}
template <int XD>
__device__ __forceinline__ void qkt(f32x16& p0, f32x16& p1, const char* Ks, const char* Xs, const bf16x8* qr, const bf16x8* qx, int r32, int hi) {
    p0 = f32x16{}; p1 = f32x16{};
#pragma unroll
    for (int d0 = 0; d0 < 8; ++d0) { const int cb = (d0 * 16 + hi * 8) * 2;
        bf16x8 b0 = *reinterpret_cast<const bf16x8*>(Ks + KSWZ(r32, cb));
        bf16x8 b1 = *reinterpret_cast<const bf16x8*>(Ks + KSWZ(32 + r32, cb));
        p0 = __builtin_amdgcn_mfma_f32_32x32x16_bf16(b0, qr[d0], p0, 0, 0, 0);
        p1 = __builtin_amdgcn_mfma_f32_32x32x16_bf16(b1, qr[d0], p1, 0, 0, 0); }
    if constexpr (XD > 0) {
#pragma unroll
        for (int d0 = 0; d0 < XD / 16; ++d0) { const int cb = (d0 * 16 + hi * 8) * 2;
            bf16x8 b0 = *reinterpret_cast<const bf16x8*>(Xs + XSWZ(r32, cb));
            bf16x8 b1 = *reinterpret_cast<const bf16x8*>(Xs + XSWZ(32 + r32, cb));
            p0 = __builtin_amdgcn_mfma_f32_32x32x16_bf16(b0, qx[d0], p0, 0, 0, 0);
            p1 = __builtin_amdgcn_mfma_f32_32x32x16_bf16(b1, qx[d0], p1, 0, 0, 0); }
    }
}
__device__ __forceinline__ int v_st(int k, int c) { const int kk = (k & ~0xC) | ((k & 4) << 1) | ((k & 8) >> 1); return ((kk >> 3) * 4 + (c >> 5)) * 512 + ((kk & 7) * 32 + (c & 31)) * 2; }
__device__ __forceinline__ int v_rd_base(int lane) { return ((lane & 3) << 3) | (((lane >> 2) & 3) << 6) | (((lane >> 4) & 1) << 5) | (((lane >> 5) & 1) << 8); }
constexpr int v_rd_off(int d0, int ks, int half) { return d0 * 512 + ks * 4096 + half * 2048; }
template <int OFF> __device__ __forceinline__ s16x4 tr_read(int vb) {
    s16x4 r; asm volatile("ds_read_b64_tr_b16 %0, %1 offset:%2" : "=&v"(r) : "v"(vb), "i"(OFF) : "memory"); return r;
}
template <int D0> __device__ __forceinline__ void pv_one(f32x16& od, int vb, bf16x8 pa0, bf16x8 pa1, bf16x8 pa2, bf16x8 pa3) {
    const s16x4 l0 = tr_read<v_rd_off(D0, 0, 0)>(vb), h0 = tr_read<v_rd_off(D0, 0, 1)>(vb), l1 = tr_read<v_rd_off(D0, 1, 0)>(vb), h1 = tr_read<v_rd_off(D0, 1, 1)>(vb);
    const s16x4 l2 = tr_read<v_rd_off(D0, 2, 0)>(vb), h2 = tr_read<v_rd_off(D0, 2, 1)>(vb), l3 = tr_read<v_rd_off(D0, 3, 0)>(vb), h3 = tr_read<v_rd_off(D0, 3, 1)>(vb);
    asm volatile("s_waitcnt lgkmcnt(0)" ::: "memory"); SBAR();
#define PK(L, H) (bf16x8){L[0], L[1], L[2], L[3], H[0], H[1], H[2], H[3]}
    od = __builtin_amdgcn_mfma_f32_32x32x16_bf16(pa0, PK(l0, h0), od, 0, 0, 0);
    od = __builtin_amdgcn_mfma_f32_32x32x16_bf16(pa1, PK(l1, h1), od, 0, 0, 0);
    od = __builtin_amdgcn_mfma_f32_32x32x16_bf16(pa2, PK(l2, h2), od, 0, 0, 0);
    od = __builtin_amdgcn_mfma_f32_32x32x16_bf16(pa3, PK(l3, h3), od, 0, 0, 0);
#undef PK
}
__device__ __forceinline__ void pv_d0(f32x16* o, int vb, bf16x8 pa0, bf16x8 pa1, bf16x8 pa2, bf16x8 pa3) {
    pv_one<0>(o[0], vb, pa0, pa1, pa2, pa3); pv_one<1>(o[1], vb, pa0, pa1, pa2, pa3); pv_one<2>(o[2], vb, pa0, pa1, pa2, pa3); pv_one<3>(o[3], vb, pa0, pa1, pa2, pa3);
}
template <int XD, int SDEPTH, int LDQ>
__device__ __forceinline__ void attn_body(const bf16_t* __restrict__ Qb, const bf16_t* __restrict__ Kh, const bf16_t* __restrict__ Vh, const bf16_t* __restrict__ Kx,
                                          bf16_t* __restrict__ Yb, int seq, char* lds, const float SCALE, const bool dry) {
    const int tid = tid_l(), wid = tid >> 6, lane = tid & 63, r32 = lane & 31, hi = lane >> 5;
    char* V_lds = lds; char* K_lds = lds + 2 * A_SHM_V; char* X_lds = lds + 2 * A_SHM_V + 2 * A_SHM_K;
    float* wsf = (float*)(lds + 2 * A_SHM_V + 2 * A_SHM_K + 2 * A_SHM_X) + wid * 64; float* li_l = wsf; float* al_l = wsf + 32;
    float m_reg = -1e30f, l_reg = 0; f32x16 o[4] = {}; bf16x8 qr[8]; bf16x8 qx[XD > 0 ? XD / 16 : 1];
    const bf16_t* Qw = Qb + (long)(wid * 32 + r32) * LDQ + hi * 8;
#pragma unroll
    for (int d0 = 0; d0 < 8; ++d0) qr[d0] = *reinterpret_cast<const bf16x8*>(Qw + d0 * 16);
    if constexpr (XD > 0) {
#pragma unroll
        for (int d0 = 0; d0 < XD / 16; ++d0) qx[d0] = *reinterpret_cast<const bf16x8*>(Qw + 128 + d0 * 16);
    }
    const int sr = tid >> 4, sc = (tid & 15) * 8, vst0 = v_st(sr, sc), vst1 = v_st(32 + sr, sc);
    const int xr = tid >> 3, xc = (tid & 7) * 8;
    const int vb0 = (int)(uintptr_t)V_lds + v_rd_base(lane);
    struct { bf16x8 vs0, vs1, ks0, ks1, xs; } sr_[SDEPTH];
#define SLOAD(i, k0) do { sr_[i].vs0 = *(const bf16x8*)(&Vh[(long)((k0) + sr) * 128 + sc]); sr_[i].vs1 = *(const bf16x8*)(&Vh[(long)((k0) + 32 + sr) * 128 + sc]); \
    sr_[i].ks0 = *(const bf16x8*)(&Kh[(long)((k0) + sr) * 128 + sc]); sr_[i].ks1 = *(const bf16x8*)(&Kh[(long)((k0) + 32 + sr) * 128 + sc]); \
    if constexpr (XD > 0) sr_[i].xs = *(const bf16x8*)(&Kx[(long)((k0) + xr) * 64 + xc]); } while (0)
#define SWRITE(b, i) do { *(bf16x8*)(V_lds + (b) * A_SHM_V + vst0) = sr_[i].vs0;          \
    *(bf16x8*)(V_lds + (b) * A_SHM_V + vst1) = sr_[i].vs1; int kc = sc * 2;               \
    *(bf16x8*)(K_lds + (b) * A_SHM_K + KSWZ(sr, kc)) = sr_[i].ks0;                       \
    *(bf16x8*)(K_lds + (b) * A_SHM_K + KSWZ(32 + sr, kc)) = sr_[i].ks1;                  \
    if constexpr (XD > 0) *(bf16x8*)(X_lds + (b) * A_SHM_X + XSWZ(xr, xc * 2)) = sr_[i].xs; } while (0)
#define SWAIT() do { if constexpr (SDEPTH == 2) { if constexpr (XD > 0) asm volatile("s_waitcnt vmcnt(5)" ::: "memory"); else asm volatile("s_waitcnt vmcnt(4)" ::: "memory"); } \
    else asm volatile("s_waitcnt vmcnt(0)" ::: "memory"); } while (0)
#define RESC(a) do { if (__any((a) < 1.f)) { if (hi == 0) al_l[r32] = (a); asm volatile("s_waitcnt lgkmcnt(0)" ::: "memory"); \
    _Pragma("unroll") for (int d = 0; d < 4; ++d) _Pragma("unroll") for (int r = 0; r < 16; ++r) o[d][r] *= al_l[crow(r, hi)]; } } while (0)
    f32x16 pA0, pA1, pB0, pB1; float mnA, mnB, alA, alB; bf16x8 pa0, pa1, pa2, pa3; const int NT = seq / 64;
    constexpr int SE = 0, SO = SDEPTH - 1;
    SLOAD(SE, 0); asm volatile("s_waitcnt vmcnt(0)" ::: "memory"); SWRITE(0, SE); __syncthreads();
    qkt<XD>(pA0, pA1, K_lds, X_lds, qr, qx, r32, hi); partialSM(pA0, pA1, m_reg, mnA, alA, SCALE);
    SLOAD(SO, 64); if constexpr (SDEPTH == 2) { if (2 < NT) SLOAD(SE, 2 * 64); }
    SWAIT(); SWRITE(1, SO); __syncthreads();
    for (int j = 1; j + 1 < NT; j += 2) {
        SBAR(); qkt<XD>(pB0, pB1, K_lds + A_SHM_K, X_lds + A_SHM_X, qr, qx, r32, hi);
        finishSM(pA0, pA1, alA, l_reg, pa0, pa1, pa2, pa3); SBAR();
        SLOAD(SO, (j + SDEPTH) * 64); SBAR();
        pv_d0(o, vb0, pa0, pa1, pa2, pa3); partialSM(pB0, pB1, m_reg, mnB, alB, SCALE);
        __syncthreads(); SWAIT(); SWRITE(0, SE);
        RESC(alB); __syncthreads();
        SBAR(); qkt<XD>(pA0, pA1, K_lds, X_lds, qr, qx, r32, hi);
        finishSM(pB0, pB1, alB, l_reg, pa0, pa1, pa2, pa3); SBAR();
        if (SDEPTH == 1 || j + 3 < NT) SLOAD(SE, (j + 1 + SDEPTH) * 64); SBAR();
        pv_d0(o, vb0 + A_SHM_V, pa0, pa1, pa2, pa3); partialSM(pA0, pA1, m_reg, mnA, alA, SCALE);
        __syncthreads(); SWAIT(); SWRITE(1, SO);
        RESC(alA); __syncthreads();
    }
    SBAR(); qkt<XD>(pB0, pB1, K_lds + A_SHM_K, X_lds + A_SHM_X, qr, qx, r32, hi);
    finishSM(pA0, pA1, alA, l_reg, pa0, pa1, pa2, pa3); SBAR();
    pv_d0(o, vb0, pa0, pa1, pa2, pa3); partialSM(pB0, pB1, m_reg, mnB, alB, SCALE);
    __syncthreads(); RESC(alB);
    finishSM(pB0, pB1, alB, l_reg, pa0, pa1, pa2, pa3); SBAR();
    pv_d0(o, vb0 + A_SHM_V, pa0, pa1, pa2, pa3);
    if (hi == 0) li_l[r32] = l_reg; asm volatile("s_waitcnt lgkmcnt(0)" ::: "memory");
    float rli[16];
#pragma unroll
    for (int r = 0; r < 16; ++r) rli[r] = __builtin_amdgcn_rcpf(li_l[crow(r, hi)]);
    bf16_t* Yw = Yb + (long)(wid * 32) * 2048;
    if (!dry)
#pragma unroll
    for (int r = 0; r < 16; ++r) { const int orow = crow(r, hi);
#pragma unroll
        for (int d0 = 0; d0 < 4; ++d0) { bf16_t* yp = Yw + (long)orow * 2048 + d0 * 32 + r32; *yp = f2bf(o[d0][r] * rli[r] * bf2f(*yp)); } }
    __syncthreads();
#undef SLOAD
#undef SWRITE
#undef SWAIT
#undef RESC
}

__device__ __forceinline__ void tconv_tile(const float* src, int ld, int k0, int sc0, bf16_t* dst, int ldd, int n0, float* tile) {
    const int tid = tid_l();
#pragma unroll
    for (int i = 0; i < 2; ++i) { const int r = (tid >> 4) + 32 * i, c = (tid & 15) * 4;
        f32x4 v = {0.f, 0.f, 0.f, 0.f}; if (sc0 >= 0) v = *(const f32x4*)(src + (size_t)(k0 + r) * ld + sc0 + c);
        tile[r * 65 + c] = v[0]; tile[r * 65 + c + 1] = v[1]; tile[r * 65 + c + 2] = v[2]; tile[r * 65 + c + 3] = v[3]; }
    __syncthreads();
    { const int n = tid >> 3, k8 = (tid & 7) * 8; float v[8];
#pragma unroll
      for (int j = 0; j < 8; ++j) v[j] = tile[(k8 + j) * 65 + n];
      *(u32x4*)(dst + (size_t)(n0 + n) * ldd + k0 + k8) = pack8(v); }
    __syncthreads();
}
__device__ __forceinline__ int wi_src(int n0) {
    if (n0 < 1280) return n0;
    if (n0 < 2304) return 1344 + (n0 - 1280);
    if (n0 < 2560) return 2368 + (n0 - 2304);
    if (n0 < 2816) return 2624 + (n0 - 2560);
    if (n0 < 2880) return 1280 + (n0 - 2816);
    if (n0 < 3072) return -1;
    return 2880 + (n0 - 3072);
}

__device__ __forceinline__ void phase_prep(const Params& p, float* ldsf) {
    const int tid = tid_l(), G = gridDim.x, bid = blockIdx.x, lane = tid & 63, wid = tid >> 6;
    unsigned char* ws = p.ws;
    if (bid == 0) { unsigned* bw = (unsigned*)(ws + OFF_BAR); for (int i = tid; i < 3456; i += 512) bw[i] = 0u; }
    float* sv = ldsf; float* red = ldsf + 3 * 2048;
    for (int i = tid; i < 3 * 2048; i += 512) { const int vec = i >> 11, k = i & 2047; const float v = vec < 2 ? p.c[vec * 2048 + k] : p.c_ctx[k]; sv[i] = silu(v); }
    __syncthreads();
    float* mod = (float*)(ws + OFF_MOD);
    for (int unit = bid; unit < 384; unit += G) {
        const int layer = unit / 192, col0 = (unit % 192) * 32, kc = tid >> 3, c4 = (tid & 7) * 4;
        const float* W = p.ada_w + (size_t)layer * 2048 * 6144 + col0 + c4;
        f32x4 a0 = {0, 0, 0, 0}, a1 = a0, a2 = a0;
#pragma unroll 4
        for (int i = 0; i < 32; ++i) { const int k = kc + 64 * i; const f32x4 w = *(const f32x4*)(W + (size_t)k * 6144);
            a0 += w * sv[k]; a1 += w * sv[2048 + k]; a2 += w * sv[4096 + k]; }
#pragma unroll
        for (int j = 0; j < 4; ++j) {
            a0[j] += xor_swz<8>(a0[j]); a1[j] += xor_swz<8>(a1[j]); a2[j] += xor_swz<8>(a2[j]);
            a0[j] += xor_swz<16>(a0[j]); a1[j] += xor_swz<16>(a1[j]); a2[j] += xor_swz<16>(a2[j]);
            { auto r0 = __builtin_amdgcn_permlane32_swap(__float_as_uint(a0[j]), __float_as_uint(a0[j]), false, false); a0[j] = __uint_as_float(r0[0]) + __uint_as_float(r0[1]);
              auto r1 = __builtin_amdgcn_permlane32_swap(__float_as_uint(a1[j]), __float_as_uint(a1[j]), false, false); a1[j] = __uint_as_float(r1[0]) + __uint_as_float(r1[1]);
              auto r2 = __builtin_amdgcn_permlane32_swap(__float_as_uint(a2[j]), __float_as_uint(a2[j]), false, false); a2[j] = __uint_as_float(r2[0]) + __uint_as_float(r2[1]); } }
        if (lane < 8) {
#pragma unroll
            for (int j = 0; j < 4; ++j) { red[(wid * 3 + 0) * 32 + c4 + j] = a0[j]; red[(wid * 3 + 1) * 32 + c4 + j] = a1[j]; red[(wid * 3 + 2) * 32 + c4 + j] = a2[j]; } }
        __syncthreads();
        if (tid < 96) { const int vec = tid >> 5, cc = tid & 31; float s = 0;
#pragma unroll
            for (int w = 0; w < 8; ++w) s += red[(w * 3 + vec) * 32 + cc];
            mod[(layer * 3 + vec) * 6144 + col0 + cc] = s + p.ada_b[layer * 6144 + col0 + cc]; }
        __syncthreads();
    }
    __syncthreads();
    float* tile = ldsf;
    for (int T = bid; T < 8224; T += G) {
        int t = T;
        if (t < 2560) { const int kt = t & 31, nt = t >> 5; tconv_tile(p.w_in_attn, 4928, kt * 64, wi_src(nt * 64), (bf16_t*)(ws + OFF_WI), LDH, nt * 64, tile); continue; }
        t -= 2560;
        if (t < 288) { const int kt = t % 12, nt = t / 12; tconv_tile(p.wq_b, 1536, kt * 64, nt * 64, (bf16_t*)(ws + OFF_WQ), 768, nt * 64, tile); continue; }
        t -= 288;
        if (t < 256) { const int kt = t & 7, nt = t >> 3; tconv_tile(p.wkv_b, 2048, kt * 64, nt * 64, (bf16_t*)(ws + OFF_WKV), 512, nt * 64, tile); continue; }
        t -= 256;
        if (t < 1024) { const int kt = t & 31, nt = t >> 5; tconv_tile(p.w_out_attn, 2048, kt * 64, nt * 64, (bf16_t*)(ws + OFF_WO), 2048, nt * 64, tile); continue; }
        t -= 1024;
        if (t < 2048) { const int kt = t & 31, nt = t >> 5; tconv_tile(p.w_in_f, 8192, kt * 64, 4096 + nt * 64, (bf16_t*)(ws + OFF_WFG), 2048, nt * 64, tile); continue; }
        t -= 2048;
        { const int kt = t & 63, nt = t >> 6; tconv_tile(p.w_out_f, 2048, kt * 64, nt * 64, (bf16_t*)(ws + OFF_WOF), 4096, nt * 64, tile); }
    }
    { bf16_t* Wub = (bf16_t*)(ws + OFF_WUB);
      for (int i = bid * 512 + tid; i < 2048 * 512; i += G * 512) { const int k = i >> 9, c8 = (i & 511) * 8;
          const f32x4 a = *(const f32x4*)(p.w_in_f + (size_t)k * 8192 + c8), b = *(const f32x4*)(p.w_in_f + (size_t)k * 8192 + c8 + 4);
          float v[8] = {a[0], a[1], a[2], a[3], b[0], b[1], b[2], b[3]}; *(u32x4*)(Wub + (size_t)k * 4096 + c8) = pack8(v); } }
    { bf16_t* Tt = (bf16_t*)(ws + OFF_TT);
      for (int i = bid * 512 + tid; i < 65536; i += G * 512) { const int j = i >> 8, n2 = i & 255; const int jj = j <= 128 ? j : j - 128;
          const float rev = (float)((jj * n2) & 255) * (1.f / 256.f); const float v = (j <= 128 ? cos_rev(rev) : sin_rev(rev)) * 0.0625f; Tt[i] = f2bf(v); } }
    { bf16_t* Tr = (bf16_t*)(ws + OFF_TRIG);
      for (int i = bid * 512 + tid; i < 512 * 1024; i += G * 512) { const int m = i >> 10, n = i & 1023, np = n & 511;
          const float rev = (float)((m * np) & 511) * (1.f / 512.f); Tr[i] = f2bf(n < 512 ? cos_rev(rev) : sin_rev(rev)); } }
}

__device__ __forceinline__ void row_stats(const f32x4 (&v)[8], float& mean, float& rstd) {
    float s = 0;
#pragma unroll
    for (int i = 0; i < 8; ++i) s += v[i][0] + v[i][1] + v[i][2] + v[i][3];
    mean = wave_sum(s) * (1.f / 2048.f);
    float q = 0;
#pragma unroll
    for (int i = 0; i < 8; ++i) { const f32x4 d = v[i] - mean; q += d[0] * d[0] + d[1] * d[1] + d[2] * d[2] + d[3] * d[3]; }
    rstd = rsqrtf(wave_sum(q) * (1.f / 2048.f) + 1e-6f);
}
__device__ __forceinline__ void mod_store(const f32x4 (&v)[8], float mean, float rstd, const float* shift, const float* scale, bf16_t* hr, int lane) {
#pragma unroll
    for (int i = 0; i < 8; ++i) { const int c = i * 256 + lane * 4; const f32x4 sc = *(const f32x4*)(scale + c), sh = *(const f32x4*)(shift + c);
        const f32x4 y = (v[i] - mean) * rstd * (sc + 1.f) + sh; u32x2 w; w.x = cvtpk(y[0], y[1]); w.y = cvtpk(y[2], y[3]); *(u32x2*)(hr + c) = w; }
}

__device__ __forceinline__ void phase_ln0(const Params& p) {
    const int tid = tid_l(), lane = tid & 63, wid = tid >> 6, G = gridDim.x;
    const float* mod = (const float*)(p.ws + OFF_MOD); bf16_t* H = (bf16_t*)(p.ws + OFF_H);
    for (int r = blockIdx.x * 8 + wid; r < NTOK; r += G * 8) {
        const float* xr; int vec;
        if (r < NLAT) { xr = p.x + (size_t)r * DM; vec = r >> 13; } else { xr = p.ctx + (size_t)(r - NLAT) * DM; vec = 2; }
        f32x4 v[8];
#pragma unroll
        for (int i = 0; i < 8; ++i) v[i] = *(const f32x4*)(xr + i * 256 + lane * 4);
        float mean, rstd; row_stats(v, mean, rstd);
        mod_store(v, mean, rstd, mod + vec * 6144, mod + vec * 6144 + 2048, H + (size_t)r * LDH, lane);
    }
}
__device__ __forceinline__ void phase_fold(const Params& p, LAS unsigned char* lds, int first_wg) {
    for (int w = (int)blockIdx.x - first_wg; w >= 0 && w < 128; w += (int)gridDim.x - first_wg) {
        const int g = w >> 3;
        pg8::Gemm gm{(const bf16_t*)(p.ws + OFF_TT), (const bf16_t*)(p.ws + OFF_WUB) + g * 256, 256, 2048, 256, 256, 4096};
        pg8::OneUnit S{0, w & 7};
        pg8::EpiB<FStore> E{FStore{(bf16_t*)(p.ws + OFF_WFU) + (size_t)g * 256 * 2048, 2048}};
        pg8::gemm_phase(lds, gm, S, E);
    }
}

__device__ __forceinline__ void phase_postz(const Params& p) {
    const int tid = tid_l(), lane = tid & 63, wid = tid >> 6, G = gridDim.x;
    unsigned char* ws = p.ws;
    const bf16_t* Z = (const bf16_t*)(ws + OFF_Z);
    bf16_t* CQN = (bf16_t*)(ws + OFF_CQN); bf16_t* CKVN = (bf16_t*)(ws + OFF_CKVN); bf16_t* QB = (bf16_t*)(ws + OFF_QB);
    bf16_t* KB = (bf16_t*)(ws + OFF_KB); bf16_t* VB = (bf16_t*)(ws + OFF_VB); bf16_t* KPE = (bf16_t*)(ws + OFF_KPE);
    for (int r = ((int)blockIdx.x - 40) * 8 + wid; r < NTOK; r += (G - 40) * 8) {
        const bf16_t* zr = Z + (size_t)r * ZW; const bool lat = r < NLAT; int b, pos, s;
        if (lat) { b = r >> 13; s = r & (SEQ - 1); pos = CTX + s; } else { const int cr = r - NLAT; b = cr >> 8; pos = cr & 255; s = 0; }
        const float prow = (float)(s >> 6), pcol = (float)(s & 63);
        float v[8];
        {
            float v2[8]; unpack8(*(const u32x4*)(zr + lane * 8), v); float ss = 0;
#pragma unroll
            for (int j = 0; j < 8; ++j) ss += v[j] * v[j];
            if (lane < 32) { unpack8(*(const u32x4*)(zr + 512 + lane * 8), v2);
#pragma unroll
                for (int j = 0; j < 8; ++j) ss += v2[j] * v2[j]; }
            const float rstd = rsqrtf(wave_sum(ss) * (1.f / 768.f) + 1e-6f);
#pragma unroll
            for (int j = 0; j < 8; ++j) v[j] = v[j] * rstd * p.q_lora_g[lane * 8 + j];
            *(u32x4*)(CQN + (size_t)r * 768 + lane * 8) = pack8(v);
            if (lane < 32) {
#pragma unroll
                for (int j = 0; j < 8; ++j) v2[j] = v2[j] * rstd * p.q_lora_g[512 + lane * 8 + j];
                *(u32x4*)(CQN + (size_t)r * 768 + 512 + lane * 8) = pack8(v2); }
        }
        {
            unpack8(*(const u32x4*)(zr + 768 + lane * 8), v); float ss = 0;
#pragma unroll
            for (int j = 0; j < 8; ++j) ss += v[j] * v[j];
            const float rstd = rsqrtf(wave_sum(ss) * (1.f / 512.f) + 1e-6f);
#pragma unroll
            for (int j = 0; j < 8; ++j) v[j] = v[j] * rstd * p.kv_lora_g[lane * 8 + j];
            *(u32x4*)(CKVN + (size_t)r * 512 + lane * 8) = pack8(v);
        }
        const int d = (lane & 15) * 8;
        {
#pragma unroll
            for (int ps = 0; ps < 2; ++ps) {
                unpack8(*(const u32x4*)(zr + 1280 + ps * 512 + lane * 8), v); float ss = 0;
#pragma unroll
                for (int j = 0; j < 8; ++j) ss += v[j] * v[j];
                const float rstd = rsqrtf(sum16(ss) * (1.f / 128.f) + 1e-6f);
#pragma unroll
                for (int j = 0; j < 8; ++j) v[j] = v[j] * rstd * p.qn_g[d + j];
                if (lat) rope8(v, d >> 1, 32, prow, pcol);
                *(u32x4*)(QB + (size_t)r * 1024 + ps * 512 + lane * 8) = pack8(v);
            }
        }
        {
            unpack8(*(const u32x4*)(zr + 2304 + lane * 8), v); float ss = 0;
#pragma unroll
            for (int j = 0; j < 8; ++j) ss += v[j] * v[j];
            const float rstd = rsqrtf(sum16(ss) * (1.f / 128.f) + 1e-6f);
            const int head = (lane >> 4) & 1; const bool isV = lane >= 32;
            if (!isV) {
#pragma unroll
                for (int j = 0; j < 8; ++j) v[j] = v[j] * rstd * p.kn_g[d + j];
                if (lat) rope8(v, d >> 1, 32, prow, pcol);
            }
            bf16_t* dst = (isV ? VB : KB) + ((size_t)((b * 2 + head) * LKV + pos) * 128 + d);
            *(u32x4*)dst = pack8(v);
        }
        if (lane < 8) {
            unpack8(*(const u32x4*)(zr + 2816 + lane * 8), v);
            if (lat) rope8(v, lane * 4, 16, prow, pcol);
            *(u32x4*)(KPE + (size_t)(b * LKV + pos) * 64 + lane * 8) = pack8(v);
        }
    }
}

__device__ __forceinline__ void phase_ln1(const Params& p) {
    const int tid = tid_l(), lane = tid & 63, wid = tid >> 6, G = gridDim.x;
    const float* mod1 = (const float*)(p.ws + OFF_MOD) + 3 * 6144; bf16_t* H1 = (bf16_t*)(p.ws + OFF_H1); const bf16_t* D0 = (const bf16_t*)p.out + 2048;
    for (int r = ((int)blockIdx.x - 16) * 8 + wid; r < NLAT; r += (G - 16) * 8) {
        const int vec = r >> 13; const float* xin = p.x + (size_t)r * DM; const bf16_t* dr = D0 + (size_t)r * 4096;
        f32x4 v[8];
#pragma unroll
        for (int i = 0; i < 8; ++i) { const int c = i * 256 + lane * 4; const f32x4 xv = *(const f32x4*)(xin + c); const u32x2 dw = *(const u32x2*)(dr + c);
            v[i] = xv * ALPHA + (f32x4){bflo(dw.x), bfhi(dw.x), bflo(dw.y), bfhi(dw.y)}; }
        float mean, rstd; row_stats(v, mean, rstd);
#pragma unroll
        for (int i = 0; i < 8; ++i) { const int c = i * 256 + lane * 4; const f32x4 g = *(const f32x4*)(p.ln_g + c), bb = *(const f32x4*)(p.ln_b + c);
            v[i] = (v[i] - mean) * rstd * g + bb; }
        row_stats(v, mean, rstd);
        mod_store(v, mean, rstd, mod1 + vec * 6144, mod1 + vec * 6144 + 2048, H1 + (size_t)r * DM, lane);
    }
}
__device__ __forceinline__ void phase_xc(const Params& p) {
    const int tid = tid_l(), lane = tid & 63, wid = tid >> 6, G = gridDim.x;
    const bf16_t* DC = (const bf16_t*)(p.ws + OFF_DC); float* XC = (float*)(p.ws + OFF_XC);
    for (int r = blockIdx.x * 8 + wid; r < NB * CTX; r += G * 8) {
        const float* xin = p.ctx + (size_t)r * DM; const bf16_t* dr = DC + (size_t)r * DM;
        f32x4 v[8];
#pragma unroll
        for (int i = 0; i < 8; ++i) { const int c = i * 256 + lane * 4; const f32x4 xv = *(const f32x4*)(xin + c); const u32x2 dw = *(const u32x2*)(dr + c);
            v[i] = xv * ALPHA + (f32x4){bflo(dw.x), bfhi(dw.x), bflo(dw.y), bfhi(dw.y)}; }
        float mean, rstd; row_stats(v, mean, rstd);
#pragma unroll
        for (int i = 0; i < 8; ++i) { const int c = i * 256 + lane * 4; const f32x4 g = *(const f32x4*)(p.ln_g + c), bb = *(const f32x4*)(p.ln_b + c);
            *(f32x4*)(XC + (size_t)r * DM + c) = (v[i] - mean) * rstd * g + bb; }
    }
}
__device__ __forceinline__ void phase_ln2(const Params& p) {
    const int tid = tid_l(), lane = tid & 63, wid = tid >> 6, G = gridDim.x;
    for (int r = blockIdx.x * 8 + wid; r < NLAT; r += G * 8) {
        float* xr = p.out + (size_t)r * DM; const float* xin = p.x + (size_t)r * DM;
        const bf16_t* d0r = (const bf16_t*)p.out + (size_t)r * 4096 + 2048; const bf16_t* d2r = (const bf16_t*)(p.ws + OFF_D2) + (size_t)r * DM;
        f32x4 v[8]; u32x2 d2w[8];
#pragma unroll
        for (int i = 0; i < 8; ++i) { const int c = i * 256 + lane * 4; const f32x4 xv = *(const f32x4*)(xin + c); const u32x2 dw = *(const u32x2*)(d0r + c); d2w[i] = *(const u32x2*)(d2r + c);
            v[i] = xv * ALPHA + (f32x4){bflo(dw.x), bfhi(dw.x), bflo(dw.y), bfhi(dw.y)}; }
        float mean, rstd; row_stats(v, mean, rstd);
#pragma unroll
        for (int i = 0; i < 8; ++i) { const int c = i * 256 + lane * 4; const f32x4 g = *(const f32x4*)(p.ln_g + c), bb = *(const f32x4*)(p.ln_b + c);
            const f32x4 x1 = (v[i] - mean) * rstd * g + bb;
            v[i] = x1 * ALPHA + (f32x4){bflo(d2w[i].x), bfhi(d2w[i].x), bflo(d2w[i].y), bfhi(d2w[i].y)}; }
        row_stats(v, mean, rstd);
#pragma unroll
        for (int i = 0; i < 8; ++i) { const int c = i * 256 + lane * 4; const f32x4 g = *(const f32x4*)(p.ln_g + DM + c), bb = *(const f32x4*)(p.ln_b + DM + c);
            *(f32x4*)(xr + c) = (v[i] - mean) * rstd * g + bb; }
    }
}

__device__ __forceinline__ void dft4(const float (&xr)[4][2], const float (&xi)[4][2], float (&tr)[4][2], float (&ti)[4][2]) {
#pragma unroll
    for (int e = 0; e < 2; ++e) {
        const float ar = xr[0][e] + xr[2][e], ai = xi[0][e] + xi[2][e], br = xr[0][e] - xr[2][e], bi = xi[0][e] - xi[2][e];
        const float cr = xr[1][e] + xr[3][e], ci = xi[1][e] + xi[3][e], dr = xr[1][e] - xr[3][e], di = xi[1][e] - xi[3][e];
        tr[0][e] = ar + cr; ti[0][e] = ai + ci;
        tr[2][e] = ar - cr; ti[2][e] = ai - ci;
        tr[1][e] = br + di; ti[1][e] = bi - dr;
        tr[3][e] = br - di; ti[3][e] = bi + dr;
    }
}
__device__ __forceinline__ void phase_radix16(const Params& p) {
    const int tid = tid_l(), G = gridDim.x, half = tid >> 8, np = (tid & 255) * 2;
    const bf16_t* PT = (const bf16_t*)(p.ws + OFF_PT); bf16_t* ZS = (bf16_t*)(p.ws + OFF_ZS);
    unsigned pw[16], qw[16];
    auto issue = [&](int u) {
        int bg, k2; if (u < 2048) { bg = u >> 6; k2 = (u & 63) * 2 + half; } else { bg = (u - 2048) * 2 + half; k2 = 128; }
        const int b = bg >> 4, g = bg & 15;
        const bf16_t* Pp = PT + (size_t)(g * 256 + k2) * NLAT + b * SEQ + np;
        const bool hasQ = (k2 >= 1 && k2 <= 127);
        const bf16_t* Qp = PT + (size_t)(g * 256 + 128 + k2) * NLAT + b * SEQ + np;
#pragma unroll
        for (int q = 0; q < 16; ++q) { pw[q] = *(const unsigned*)(Pp + 512 * q); qw[q] = hasQ ? *(const unsigned*)(Qp + 512 * q) : 0u; }
    };
    if ((int)blockIdx.x < 2064) issue(blockIdx.x);
    for (int u = blockIdx.x; u < 2064; u += G) {
        int bg, k2; if (u < 2048) { bg = u >> 6; k2 = (u & 63) * 2 + half; } else { bg = (u - 2048) * 2 + half; k2 = 128; }
        float zr[16][2], zi[16][2];
#pragma unroll
        for (int q = 0; q < 16; ++q) { zr[q][0] = bflo(pw[q]); zr[q][1] = bfhi(pw[q]); zi[q][0] = -bflo(qw[q]); zi[q][1] = -bfhi(qw[q]); }
        if (u + G < 2064) issue(u + G);
        float ur[4][4][2], ui[4][4][2];
#pragma unroll
        for (int q0 = 0; q0 < 4; ++q0) {
            float xr[4][2], xi[4][2], tr[4][2], ti[4][2];
#pragma unroll
            for (int q1 = 0; q1 < 4; ++q1) { xr[q1][0] = zr[4 * q1 + q0][0]; xr[q1][1] = zr[4 * q1 + q0][1]; xi[q1][0] = zi[4 * q1 + q0][0]; xi[q1][1] = zi[4 * q1 + q0][1]; }
            dft4(xr, xi, tr, ti);
#pragma unroll
            for (int s0 = 0; s0 < 4; ++s0) {
                constexpr float C16[10] = {1.f, 0.92387953251128674f, 0.70710678118654752f, 0.38268343236508977f, 0.f, -0.38268343236508977f, -0.70710678118654752f, -0.92387953251128674f, -1.f, -0.92387953251128674f};
                constexpr float S16[10] = {0.f, 0.38268343236508977f, 0.70710678118654752f, 0.92387953251128674f, 1.f, 0.92387953251128674f, 0.70710678118654752f, 0.38268343236508977f, 0.f, -0.38268343236508977f};
                const float ck = C16[s0 * q0], sk = S16[s0 * q0];
#pragma unroll
                for (int e = 0; e < 2; ++e) { ur[q0][s0][e] = tr[s0][e] * ck + ti[s0][e] * sk; ui[q0][s0][e] = ti[s0][e] * ck - tr[s0][e] * sk; }
            }
        }
#pragma unroll
        for (int s0 = 0; s0 < 4; ++s0) {
            float xr[4][2], xi[4][2], yr[4][2], yi[4][2];
#pragma unroll
            for (int q0 = 0; q0 < 4; ++q0) { xr[q0][0] = ur[q0][s0][0]; xr[q0][1] = ur[q0][s0][1]; xi[q0][0] = ui[q0][s0][0]; xi[q0][1] = ui[q0][s0][1]; }
            dft4(xr, xi, yr, yi);
#pragma unroll
            for (int s1 = 0; s1 < 4; ++s1) {
                const int sq = s0 + 4 * s1; float a[2], bq[2];
#pragma unroll
                for (int e = 0; e < 2; ++e) { const float rev = (float)(sq * (np + e)) * (1.f / 8192.f); const float cs = cos_rev(rev), sn = sin_rev(rev);
                    a[e] = yr[s1][e] * cs + yi[s1][e] * sn; bq[e] = yi[s1][e] * cs - yr[s1][e] * sn; }
                const size_t rho = (u < 2048) ? (size_t)((bg * 16 + sq) * 128 + k2) : (size_t)(65536 + bg * 16 + sq);
                *(unsigned*)(ZS + rho * 1024 + np) = cvtpk(a[0], a[1]);
                *(unsigned*)(ZS + rho * 1024 + 512 + np) = cvtpk(bq[0], bq[1]);
            }
        }
    }
}

__device__ __forceinline__ void phase_combine(const Params& p) {
    const int tid = tid_l(), lane = tid & 63, wid = tid >> 6, G = gridDim.x;
    const bf16_t* XR = (const bf16_t*)(p.ws + OFF_XR); const bf16_t* XR128 = (const bf16_t*)(p.ws + OFF_XR128); bf16_t* SG = (bf16_t*)(p.ws + OFF_SG);
    constexpr float NRM = 0.011048543456039806f;
    for (int r = blockIdx.x * 8 + wid; r < NLAT; r += G * 8) {
        const int b = r >> 13, k1 = r & (SEQ - 1), rm = b * SEQ + ((SEQ - k1) & (SEQ - 1));
        const bf16_t* x0 = XR + (size_t)r * 2048; const bf16_t* xm = XR + (size_t)rm * 2048; bf16_t* sg = SG + (size_t)r * 4096;
#pragma unroll
        for (int it = 0; it < 8; ++it) {
            const int c0 = (it * 64 + lane) * 8, g = c0 >> 8, k20 = c0 & 255;
            float f[8], gt[8]; unpack8(*(const u32x4*)(sg + c0), gt);
            if (k20 < 128) unpack8(*(const u32x4*)(x0 + g * 128 + k20), f);
            else {
#pragma unroll
                for (int j = 0; j < 8; ++j) { const int k2 = k20 + j; f[j] = (k2 == 128) ? bf2f(XR128[(size_t)r * 16 + g]) : bf2f(xm[g * 128 + 256 - k2]); } }
#pragma unroll
            for (int j = 0; j < 8; ++j) f[j] = f[j] * NRM * gt[j];
            *(u32x4*)(sg + c0) = pack8(f);
        }
    }
}

#define XB_TMO      128
#define XB_XCNT(j)  (256  + 64 * (j))
#define XB_XSUB(j)  (1280 + 64 * (j))
#define XB_XGEN(j)  (2304 + 64 * (j))
#define XB_TOP      3328
#define XB_TOPGEN   3392
#define XCD_BAR_WORDS 3456
#define XB_SPIN_CAP (1u << 20)
__device__ __forceinline__ unsigned xb_ld(unsigned* p)              { return __hip_atomic_load(p, __ATOMIC_RELAXED, __HIP_MEMORY_SCOPE_AGENT); }
__device__ __forceinline__ unsigned xb_add(unsigned* p, unsigned v) { return __hip_atomic_fetch_add(p, v, __ATOMIC_RELAXED, __HIP_MEMORY_SCOPE_AGENT); }
__device__ __forceinline__ unsigned xb_xcc_id() { return (unsigned)__builtin_amdgcn_s_getreg((3 << 11) | 20) & 0xFu; }
#define XB_SPIN(cond, bar) do { unsigned _sp = 0; while (cond) { __builtin_amdgcn_s_sleep(1); \
    if ((++_sp & 255u) == 0u) { if (xb_ld(&(bar)[XB_TMO])) break; if (_sp > XB_SPIN_CAP) { atomicAdd(&(bar)[XB_TMO], 1u); break; } } } } while (0)
struct XcdBarrier { unsigned* bar; unsigned x; volatile LAS unsigned* st; };
__device__ __forceinline__ XcdBarrier xcd_barrier_post(unsigned* bar, volatile LAS unsigned* st) {
    XcdBarrier b; b.bar = bar; b.x = xb_xcc_id(); b.st = st;
    if (threadIdx.x == 0) (void)xb_add(&bar[XB_XCNT(b.x)], 1u);
    return b;
}
__device__ __forceinline__ void xcd_barrier_complete(unsigned* bar, unsigned x, unsigned& nloc, unsigned& nx) {
    const unsigned G = gridDim.x * gridDim.y * gridDim.z;
    unsigned sum, cnt, mine, sp = 0u;
    for (;;) {
        sum = 0u; cnt = 0u; mine = 0u;
#pragma unroll
        for (unsigned j = 0; j < 16; ++j) { const unsigned c = xb_ld(&bar[XB_XCNT(j)]); sum += c; cnt += (c > 0u) ? 1u : 0u; mine = (j == x) ? c : mine; }
        if (sum == G) break;
        __builtin_amdgcn_s_sleep(1);
        if ((++sp & 255u) == 0u) { if (xb_ld(&bar[XB_TMO])) break; if (sp > XB_SPIN_CAP) { atomicAdd(&bar[XB_TMO], 1u); break; } }
    }
    nloc = mine > 0u ? mine : 1u; nx = cnt > 0u ? cnt : 1u;
}
__device__ __forceinline__ void xcd_barrier(const XcdBarrier& b) {
    asm volatile("s_waitcnt vmcnt(0)" ::: "memory");
    __syncthreads();
    if (threadIdx.x == 0) {
        unsigned* bar = b.bar;
        __builtin_amdgcn_s_waitcnt(0);
        unsigned nloc = b.st[0], nx = b.st[1];
        if (nloc == 0u) { xcd_barrier_complete(bar, b.x, nloc, nx); b.st[0] = nloc; b.st[1] = nx; }
        const unsigned old = xb_add(&bar[XB_XSUB(b.x)], 1u);
        const unsigned gen = old / nloc;
        if (old + 1u == (gen + 1u) * nloc) {
            __builtin_amdgcn_fence(__ATOMIC_RELEASE, "agent");
            asm volatile("s_waitcnt vmcnt(0)" ::: "memory");
            const unsigned og = xb_add(&bar[XB_TOP], 1u);
            const unsigned tg = og / nx;
            if (og + 1u == (tg + 1u) * nx) xb_add(&bar[XB_TOPGEN], 1u);
            else XB_SPIN(xb_ld(&bar[XB_TOPGEN]) == tg, bar);
            __builtin_amdgcn_fence(__ATOMIC_ACQUIRE, "agent");
            xb_add(&bar[XB_XGEN(b.x)], 1u);
            asm volatile("s_waitcnt vmcnt(0)" ::: "memory");
        } else {
            XB_SPIN(xb_ld(&bar[XB_XGEN(b.x)]) == gen, bar);
            __builtin_amdgcn_fence(__ATOMIC_ACQUIRE, "agent");
            asm volatile("s_waitcnt vmcnt(0)" ::: "memory");
        }
    }
    __syncthreads();
}

__global__ __launch_bounds__(512) void mega(Params p) {
    extern __shared__ __attribute__((aligned(16))) unsigned char shm[];
    cg::grid_group grid = cg::this_grid();
    LAS unsigned char* lds = (LAS unsigned char*)shm;
    unsigned char* ws = p.ws;
    const int G = gridDim.x, bid = blockIdx.x;
    const float* mod = (const float*)(ws + OFF_MOD);
    volatile LAS unsigned* bst = (volatile LAS unsigned*)(lds + LDS_STAGE);
    if (threadIdx.x < 2) bst[threadIdx.x] = 0u;
    __syncthreads();
    XcdBarrier xb; xb.bar = (unsigned*)(ws + OFF_BAR); xb.x = 0; xb.st = bst;
    for (int ph = p.ph_lo; ph < p.ph_hi; ++ph) {
      const int reps = (ph == REP_PH) ? 2 : 1;
      for (int rep = 0; rep < reps; ++rep) {
        const bool dry = rep + 1 < reps; (void)dry;
        if (rep) grid.sync();
        if (((STAGGER_MASK >> ph) & 1) && ((bid >> 3) & 1)) {
            const unsigned long long t0 = __builtin_amdgcn_s_memrealtime(); while (__builtin_amdgcn_s_memrealtime() - t0 < STAGGER_TICKS) __builtin_amdgcn_s_sleep(8); }
        if (PH_ON(0) && ph == 0) phase_prep(p, (float*)shm);
        else if (PH_ON(1) && ph == 1) phase_ln0(p);
        else if (PH_ON(3) && ph == 3 && bid >= 40) phase_postz(p);
        else if (PH_ON(2) && (ph == 2 || ph == 3)) {
            {
                pg8::Gemm gm{(const bf16_t*)(ws + OFF_H), (const bf16_t*)(ws + OFF_WI), NTOK, NWI, 2048, LDH, LDH};
                pg8::MixOrder S; S.so.init(64 * 256, NWI, G, bid); S.one = (ph == 3); S.remap = true; S.pm = 61 + (bid >> 3); S.pn = 12 + (bid & 7);
                pg8::EpiB<FZ> E{FZ{(bf16_t*)(ws + OFF_Z), (bf16_t*)(ws + OFF_SG0)}};
                pg8::gemm_phase(lds, gm, S, E);
            }
        }
        else if (PH_ON(4) && ph == 4) {
            { pg8::Gemm gm{(const bf16_t*)(ws + OFF_CQN), (const bf16_t*)(ws + OFF_WQ), NTOK, 1536, 768, 768, 768};
              pg8::StaticOrder S; S.init(gm.M, gm.N, G, bid);
              pg8::EpiB<FQa> E{FQa{(bf16_t*)(ws + OFF_QA)}};
              pg8::gemm_phase(lds, gm, S, E); }
            { pg8::Gemm gm{(const bf16_t*)(ws + OFF_CKVN), (const bf16_t*)(ws + OFF_WKV), NTOK, 2048, 512, 512, 512};
              pg8::StaticOrder S; S.init(gm.M, gm.N, G, (bid + G - 140) % G);
              pg8::EpiB<FKva> E{FKva{(bf16_t*)(ws + OFF_KA), (bf16_t*)(ws + OFF_VA)}};
              pg8::gemm_phase(lds, gm, S, E); }
            phase_fold(p, lds, 156);
        }
        else if (PH_ON(5) && ph == 5) {
            bf16_t* Y = (bf16_t*)(ws + OFF_SG0);
            for (int u = bid; u < 256; u += G) {
                const int qblk = u >> 3;
                const int nA = (u < 16) ? 3 : 2, nB = (u >= 16 && u < 32) ? 3 : 2;
                for (int it = 0; it < nA; ++it) {
                    const int b = it < 2 ? it : ((u >> 3) & 1), head = u & 7, seq = it < 2 ? LKV : CTX;
                    const size_t t0 = it < 2 ? (size_t)b * SEQ + qblk * 256 : (size_t)NLAT + b * CTX;
                    attn_body<64, 1, 1536>((const bf16_t*)(ws + OFF_QA) + t0 * 1536 + head * 192,
                                           (const bf16_t*)(ws + OFF_KA) + (size_t)(b * 8 + head) * LKV * 128, (const bf16_t*)(ws + OFF_VA) + (size_t)(b * 8 + head) * LKV * 128,
                                           (const bf16_t*)(ws + OFF_KPE) + (size_t)b * LKV * 64, Y + t0 * 2048 + head * 128, seq, (char*)shm, 0.07216878364870322f, dry);
                }
                for (int it = 0; it < nB; ++it) {
                    const int b = it < 2 ? it : ((u >> 3) & 1), head = u & 7, kvh = head >> 2, seq = it < 2 ? LKV : CTX;
                    const size_t t0 = it < 2 ? (size_t)b * SEQ + qblk * 256 : (size_t)NLAT + b * CTX;
                    attn_body<0, 2, 1024>((const bf16_t*)(ws + OFF_QB) + t0 * 1024 + head * 128,
                                          (const bf16_t*)(ws + OFF_KB) + (size_t)(b * 2 + kvh) * LKV * 128, (const bf16_t*)(ws + OFF_VB) + (size_t)(b * 2 + kvh) * LKV * 128,
                                          nullptr, Y + t0 * 2048 + 1024 + head * 128, seq, (char*)shm, 0.08838834764831845f, dry);
                }
            }
        }
        else if (PH_ON(6) && (ph == 6 || ph == 7)) {
            if (ph == 6 || bid < 16) {
                pg8::Gemm gm{(const bf16_t*)(ws + OFF_SG0), (const bf16_t*)(ws + OFF_WO), NLAT, 2048, 2048, 2048, 2048};
                pg8::MixOrder S; S.so.init(gm.M, gm.N, G, bid); S.one = (ph == 7); S.remap = false; S.pm = 64 + (bid >> 3); S.pn = bid & 7;
                pg8::EpiB<FDelta> E{FDelta{mod + 4096, ph == 6 ? (bf16_t*)p.out + 2048 : (bf16_t*)(ws + OFF_DC) - (size_t)NLAT * DM, ph == 6 ? 4096 : 2048}};
                pg8::gemm_phase(lds, gm, S, E);
            } else phase_ln1(p);
        }
        else if (PH_ON(8) && ph == 8) {
            phase_xc(p);
            { pg8::Gemm gm{(const bf16_t*)(ws + OFF_WFU), (const bf16_t*)(ws + OFF_H1), 4096, NLAT, 2048, 2048, 2048};
              pg8::StaticOrder S; S.init(gm.M, gm.N, G, bid);
              pg8::EpiB<FStore> E{FStore{(bf16_t*)(ws + OFF_PT), NLAT}};
              pg8::gemm_phase(lds, gm, S, E); }
        }
        else if (PH_ON(9) && ph == 9) phase_radix16(p);
        else if (PH_ON(10) && ph == 10) {
            pg8::Gemm gm{(const bf16_t*)(ws + OFF_TRIG), (const bf16_t*)(ws + OFF_ZS), 512, NZS, 1024, 1024, 1024};
            pg8::StaticOrder S; S.init(gm.M, gm.N, G, bid);
            pg8::EpiB<FXr> E{FXr{(bf16_t*)(ws + OFF_XR), (bf16_t*)(ws + OFF_XR128)}};
            pg8::gemm_phase(lds, gm, S, E);
        }
        else if (PH_ON(11) && ph == 11) {
            pg8::Gemm gm{(const bf16_t*)(ws + OFF_H1), (const bf16_t*)(ws + OFF_WFG), NLAT, 4096, 2048, 2048, 2048};
            pg8::StaticOrder S; S.init(gm.M, gm.N, G, bid);
            pg8::EpiB<FGate> E{FGate{(const bf16_t*)(ws + OFF_XR), (const bf16_t*)(ws + OFF_XR128), (bf16_t*)(ws + OFF_SG)}};
            pg8::gemm_phase(lds, gm, S, E);
        }
        else if (PH_ON(12) && ph == 12) {
            pg8::Gemm gm{(const bf16_t*)(ws + OFF_SG), (const bf16_t*)(ws + OFF_WOF), NLAT, 2048, 4096, 4096, 4096};
            pg8::StaticOrder S; S.init(gm.M, gm.N, G, bid);
            pg8::EpiB<FDelta> E{FDelta{mod + 3 * 6144 + 4096, (bf16_t*)(ws + OFF_D2), 2048}};
            pg8::gemm_phase(lds, gm, S, E);
        }
        else if (PH_ON(13) && ph == 13) phase_ln2(p);
      }
        if (ph + 1 < p.ph_hi) {
            if (ph == 0) { grid.sync(); xb = xcd_barrier_post((unsigned*)(ws + OFF_BAR), bst); }
            else xcd_barrier(xb); }
    }
}

extern "C" void kernel_launch(void* const* d_in, const int* in_sizes, int n_in, void* d_out, int out_size, void* d_ws, size_t ws_size, hipStream_t stream) {
    static int grid = 0;
    if (grid == 0) {
        if (n_in != 18 || in_sizes[0] != NLAT * DM || out_size != NLAT * DM || ws_size < WS_NEED) {
            fprintf(stderr, "kernel_launch: shape/workspace mismatch (n_in %d, in0 %d, out %d, ws %zu, need %zu)\n", n_in, n_in > 0 ? in_sizes[0] : -1, out_size, ws_size, (size_t)WS_NEED); grid = -1; return; }
        int dev = 0, cus = 0, per_cu = 0;
        (void)hipGetDevice(&dev); (void)hipDeviceGetAttribute(&cus, hipDeviceAttributeMultiprocessorCount, dev);
        if (hipFuncSetAttribute((const void*)mega, hipFuncAttributeMaxDynamicSharedMemorySize, LDS_BYTES) != hipSuccess) { fprintf(stderr, "kernel_launch: hipFuncSetAttribute failed\n"); grid = -1; return; }
        if (hipOccupancyMaxActiveBlocksPerMultiprocessor(&per_cu, (const void*)mega, 512, LDS_BYTES) != hipSuccess || per_cu < 1) { fprintf(stderr, "kernel_launch: occupancy query says %d\n", per_cu); per_cu = 1; }
        (void)hipGetLastError();
        grid = cus * 1;
        if (grid > 256) grid = 256;
    }
    if (grid < 0) return;
    Params p{};
    p.x = (const float*)d_in[0]; p.c = (const float*)d_in[1]; p.ctx = (const float*)d_in[2]; p.c_ctx = (const float*)d_in[3]; p.ada_w = (const float*)d_in[4]; p.ada_b = (const float*)d_in[5];
    p.ln_g = (const float*)d_in[6]; p.ln_b = (const float*)d_in[7]; p.w_in_attn = (const float*)d_in[8]; p.wq_b = (const float*)d_in[9]; p.q_lora_g = (const float*)d_in[10];
    p.kv_lora_g = (const float*)d_in[11]; p.wkv_b = (const float*)d_in[12]; p.qn_g = (const float*)d_in[13]; p.kn_g = (const float*)d_in[14]; p.w_out_attn = (const float*)d_in[15];
    p.w_in_f = (const float*)d_in[16]; p.w_out_f = (const float*)d_in[17]; p.out = (float*)d_out; p.ws = (unsigned char*)d_ws;
#if MK_MULTI
    for (int ph = 0; ph < NPH; ++ph) { p.ph_lo = ph; p.ph_hi = ph + 1; hipLaunchKernelGGL(mega, dim3(grid), dim3(512), LDS_BYTES, stream, p); }
#else
    p.ph_lo = 0; p.ph_hi = NPH;
    void* args[] = {&p};
    hipError_t e = hipLaunchCooperativeKernel((const void*)mega, dim3(grid), dim3(512), args, LDS_BYTES, stream);
    if (e != hipSuccess) fprintf(stderr, "kernel_launch: cooperative launch failed: %s (grid %d)\n", hipGetErrorString(e), grid);
#endif
}
```

```cpp
#include <hip/hip_runtime.h>
#include <hip/hip_cooperative_groups.h>
#include <cstdio>
#include <cstdint>
namespace cg = cooperative_groups;

#ifndef MK_MULTI
#define MK_MULTI 0
#endif
#ifndef PHMASK
#define PHMASK 0xffff
#endif
#define PH_ON(n) ((PHMASK >> (n)) & 1)
#ifndef STAGGER_TICKS
#define STAGGER_TICKS 2200ull
#endif
#ifndef STAGGER_MASK
#define STAGGER_MASK 0x0
#endif
#ifndef REP_PH
#define REP_PH -1
#endif

typedef unsigned short bf16_t;
typedef short bf16x8 __attribute__((ext_vector_type(8)));
typedef short s16x4 __attribute__((ext_vector_type(4)));
typedef float f32x4 __attribute__((ext_vector_type(4)));
typedef float f32x16 __attribute__((ext_vector_type(16)));
typedef unsigned u32x4 __attribute__((ext_vector_type(4)));
typedef unsigned u32x2 __attribute__((ext_vector_type(2)));
#define LAS __attribute__((address_space(3)))

constexpr int DM = 2048, NB = 2, SEQ = 8192, CTX = 256, NLAT = NB * SEQ, NTOK = NLAT + NB * CTX, LKV = SEQ + CTX;
constexpr int ZW = 3072;
constexpr int NWI = 5120;
constexpr float ALPHA = 1.4142135623730951f;
constexpr int LDY = 4096 + 64;
constexpr int NPH = 14;
constexpr int LDS_STAGE = 131072;
constexpr int LDS_BYTES = LDS_STAGE + 256;

constexpr size_t al256(size_t x) { return (x + 255) / 256 * 256; }
constexpr size_t OFF_WI = 0;
constexpr size_t OFF_WQ = OFF_WI + (size_t)NWI * 2048 * 2;
constexpr size_t OFF_WKV = OFF_WQ + (size_t)1536 * 768 * 2;
constexpr size_t OFF_WO = OFF_WKV + (size_t)2048 * 512 * 2;
constexpr size_t OFF_WFU = OFF_WO + (size_t)2048 * 2048 * 2;
constexpr size_t OFF_WFG = OFF_WFU + (size_t)4096 * 2048 * 2;
constexpr size_t OFF_WOF = OFF_WFG + (size_t)4096 * 2048 * 2;
constexpr size_t OFF_WUB = OFF_WOF + (size_t)2048 * LDY * 2;
constexpr size_t OFF_TT = OFF_WUB + (size_t)2048 * 4096 * 2;
constexpr size_t OFF_TRIG = OFF_TT + (size_t)256 * 256 * 2;
constexpr size_t OFF_MOD = OFF_TRIG + (size_t)1024 * 2048 * 2;
constexpr size_t OFF_BAR = al256(OFF_MOD + (size_t)2 * 3 * 6144 * 4);
constexpr size_t OFF_L = al256(OFF_BAR + (size_t)3456 * 4);
constexpr size_t OFF_H = OFF_L;
constexpr size_t OFF_CQN = OFF_H;
constexpr size_t OFF_CKVN = OFF_CQN + (size_t)NTOK * 768 * 2;
constexpr size_t OFF_Z = OFF_H + (size_t)NTOK * 2048 * 2;
constexpr size_t OFF_SG0 = OFF_Z + (size_t)NTOK * ZW * 2;
constexpr size_t OFF_QB = OFF_SG0 + (size_t)NTOK * 2048 * 2;
constexpr size_t OFF_KB = OFF_QB + (size_t)NTOK * 1024 * 2;
constexpr size_t OFF_VB = OFF_KB + (size_t)NB * 2 * LKV * 128 * 2;
constexpr size_t OFF_KPE = OFF_VB + (size_t)NB * 2 * LKV * 128 * 2;
constexpr size_t OFF_QA = OFF_KPE + (size_t)NB * LKV * 64 * 2;
constexpr size_t OFF_KA = OFF_QA + (size_t)NTOK * 1536 * 2;
constexpr size_t OFF_VA = OFF_KA + (size_t)NB * 8 * LKV * 128 * 2;
constexpr size_t OFF_DC = OFF_WI + (size_t)NB * CTX * DM * 4;
constexpr size_t OFF_XC = OFF_WI;
constexpr size_t OFF_D0 = OFF_Z;
constexpr size_t END0 = OFF_VA + (size_t)NB * 8 * LKV * 128 * 2;
constexpr int NZS = 66048;
constexpr size_t OFF_ZS = OFF_L;
constexpr size_t OFF_SG = OFF_ZS;
constexpr size_t OFF_PT = OFF_ZS + (size_t)NLAT * LDY * 2;
constexpr size_t OFF_XR = OFF_PT;
constexpr size_t OFF_XR128 = OFF_XR + (size_t)NLAT * 2048 * 2;
constexpr size_t OFF_H1 = OFF_PT + (size_t)4096 * NLAT * 2;
constexpr size_t OFF_D2 = OFF_H1 + (size_t)NLAT * 2048 * 2;
constexpr size_t END1 = OFF_D2 + (size_t)NLAT * 2048 * 2;
constexpr size_t WS_NEED = END0 > END1 ? END0 : END1;

struct Params {
    const float *x, *c, *ctx, *c_ctx, *ada_w, *ada_b, *ln_g, *ln_b, *w_in_attn, *wq_b, *q_lora_g, *kv_lora_g, *wkv_b, *qn_g, *kn_g, *w_out_attn, *w_in_f, *w_out_f;
    float* out; unsigned char* ws; int ph_lo, ph_hi;
};

__device__ __forceinline__ unsigned cvtpk(float lo, float hi) { unsigned r; asm("v_cvt_pk_bf16_f32 %0, %1, %2" : "=v"(r) : "v"(lo), "v"(hi)); return r; }
__device__ __forceinline__ int tid_l() { int t = threadIdx.x; asm volatile("" : "+v"(t)); return t; }
__device__ __forceinline__ int bid_l() { int t = blockIdx.x; asm volatile("" : "+s"(t)); return t; }
__device__ __forceinline__ float bflo(unsigned w) { return __uint_as_float(w << 16); }
__device__ __forceinline__ float bfhi(unsigned w) { return __uint_as_float(w & 0xffff0000u); }
__device__ __forceinline__ float bf2f(bf16_t b) { return __uint_as_float(((unsigned)b) << 16); }
__device__ __forceinline__ bf16_t f2bf(float f) { return (bf16_t)(cvtpk(f, 0.f) & 0xffffu); }
template <int O> __device__ __forceinline__ float xor_swz(float v) {
    return __int_as_float(__builtin_amdgcn_ds_swizzle(__float_as_int(v), 0x1F | (O << 10))); }
__device__ __forceinline__ float xor32(float v) {
    auto rr = __builtin_amdgcn_permlane32_swap(__float_as_uint(v), __float_as_uint(v), false, false);
    const float a = __uint_as_float(rr[0]), b = __uint_as_float(rr[1]);
    return (a == v) ? b : a;
}
__device__ __forceinline__ float sum16(float v) { v += xor_swz<8>(v); v += xor_swz<4>(v); v += xor_swz<2>(v); v += xor_swz<1>(v); return v; }
__device__ __forceinline__ float wave_sum(float v) {
    v += xor_swz<16>(v); v = sum16(v);
    auto rr = __builtin_amdgcn_permlane32_swap(__float_as_uint(v), __float_as_uint(v), false, false);
    return __uint_as_float(rr[0]) + __uint_as_float(rr[1]);
}
__device__ __forceinline__ float silu(float x) { return x / (1.f + __expf(-x)); }
__device__ __forceinline__ void unpack8(u32x4 w, float (&v)[8]) {
    v[0] = bflo(w.x); v[1] = bfhi(w.x); v[2] = bflo(w.y); v[3] = bfhi(w.y); v[4] = bflo(w.z); v[5] = bfhi(w.z); v[6] = bflo(w.w); v[7] = bfhi(w.w);
}
__device__ __forceinline__ u32x4 pack8(const float (&v)[8]) { u32x4 w; w.x = cvtpk(v[0], v[1]); w.y = cvtpk(v[2], v[3]); w.z = cvtpk(v[4], v[5]); w.w = cvtpk(v[6], v[7]); return w; }
__device__ __forceinline__ float cos_rev(float r) { return __builtin_amdgcn_cosf(r); }
__device__ __forceinline__ float sin_rev(float r) { return __builtin_amdgcn_sinf(r); }
__device__ __forceinline__ void rope8(float (&v)[8], int i0, int nhalf, float prow, float pcol) {
#pragma unroll
    for (int j = 0; j < 4; ++j) {
        const int i = i0 + j; const int fi = i < nhalf ? i : i - nhalf; const float pos = i < nhalf ? prow : pcol;
        const float inv = __builtin_amdgcn_exp2f(-(float)fi * (13.287712379549449f / (float)nhalf));
        const float rev = pos * inv * 0.15915494309189535f;
        const float cs = cos_rev(rev), sn = sin_rev(rev), a = v[2 * j], b = v[2 * j + 1];
        v[2 * j] = a * cs - b * sn; v[2 * j + 1] = a * sn + b * cs;
    }
}

namespace pg8 {
constexpr int BM = 256, BK = 64, HALF = 128, HTB = HALF * BK * 2, NXCD = 8, WGM = 3;
__device__ __forceinline__ int lds_byte(int r, int c) { const int st = (r >> 4) * 2 + (c >> 5), rr = r & 15, cc = c & 31, ob = rr * 64 + cc * 2; return st * 1024 + (ob ^ (((ob >> 9) & 1) << 5)); }
__device__ __forceinline__ void stage_rc(int b, int& R, int& C) { const int st = b / 1024, sb = b % 1024, swz = sb ^ (((sb >> 9) & 1) << 5); R = (st >> 1) * 16 + swz / 64; C = (st & 1) * 32 + (swz % 64) / 2; }
__device__ __forceinline__ int perm32(int rho) { const int n = rho >> 4, i = rho & 15; return 8 * (i >> 2) + 4 * n + (i & 3); }
struct Unit { int pm, pn; };
struct Gemm { const bf16_t* A; const bf16_t* Bt; int M, N, K, lda, ldb; };
struct StaticOrder {
    int nM, nN, nwg, G, c;
    __device__ void init(int M, int N, int G_, int c_) { nM = M / BM; nN = N / BM; nwg = nM * nN; G = G_; c = c_; }
    __device__ bool next(int i, Unit& u) const {
        const long L = (long)i * G + c; if (L >= nwg) return false;
        int wgid = (int)L; { const int q = nwg / NXCD, r = nwg % NXCD, xcd = wgid % NXCD, off = wgid / NXCD; wgid = (xcd < r ? xcd * (q + 1) : r * (q + 1) + (xcd - r) * q) + off; }
        const int nig = WGM * nN, gid = wgid / nig, fm = gid * WGM, gsz = (nM - fm) < WGM ? (nM - fm) : WGM;
        u.pm = fm + ((wgid % nig) % gsz); u.pn = (wgid % nig) / gsz; return true;
    }
};
struct MixOrder { StaticOrder so; int pm, pn; bool one, remap;
    __device__ bool next(int i, Unit& u) const {
        if (!one) { if (!so.next(i, u)) return false; if (remap && u.pm >= 61) { const int q = (u.pm - 61) * 20 + u.pn; u.pm = 61 + q / 12; u.pn = q % 12; } return true; }
        if (i) return false; u.pm = pm; u.pn = pn; return true; } };
struct OneUnit { int pm, pn; __device__ bool next(int i, Unit& u) const { if (i) return false; u.pm = pm; u.pn = pn; return true; } };

template <class Epi, class Sched>
__device__ __forceinline__ void gemm_phase(LAS unsigned char* lds, const Gemm g, const Sched& S, const Epi& E) {
    const int tid = tid_l(), wid = __builtin_amdgcn_readfirstlane(tid >> 6), lane = tid & 63, wr = wid >> 2, wc = wid & 3, fr = lane & 15, fq = lane >> 4;
    const int K = g.K, nt = K / BK;
    unsigned voffA[2], voffB[2];
#pragma unroll
    for (int i = 0; i < 2; ++i) { int R, C; stage_rc(tid * 16 + i * 8192, R, C); const int Rb = Epi::PERM ? ((R & ~31) + perm32(R & 31)) : R;
        voffA[i] = (unsigned)(R * g.lda + C) * 2u; voffB[i] = (unsigned)(Rb * g.ldb + C) * 2u; }
    const size_t kstep = (size_t)(BK * 2);
    const size_t hsA = (size_t)HALF * g.lda * 2, hsB = (size_t)HALF * g.ldb * 2;
    const size_t tsA = 2 * hsA, tsB = 2 * hsB;
    const unsigned ldsw = (unsigned)wid * 1024u;
    const int aoff = lds_byte(wr * 64 + fr, fq * 8), boff = lds_byte(wc * 32 + fr, fq * 8);
#define PG8_SA(b, h) (((b) * 2 + (h)) * HTB)
#define PG8_SB(b, h) ((4 + (b) * 2 + (h)) * HTB)
#define PG8_STAGE(bufoff, gbase, voff) do { _Pragma("unroll") for (int _i = 0; _i < 2; ++_i) \
        __builtin_amdgcn_global_load_lds((const unsigned*)((const char*)(gbase) + (voff)[_i]), (LAS unsigned*)(lds + (bufoff) + ldsw + _i * 8192), 16, 0, 0); } while (0)
#define PG8_LDA(dst, b, h) do { _Pragma("unroll") for (int m = 0; m < 4; ++m) _Pragma("unroll") for (int k = 0; k < 2; ++k) dst[m][k] = *(const LAS bf16x8*)(lds + PG8_SA(b, h) + aoff + m * 2048 + k * 1024); } while (0)
#define PG8_LDB(dst, b, h) do { _Pragma("unroll") for (int n = 0; n < 2; ++n) _Pragma("unroll") for (int k = 0; k < 2; ++k) dst[n][k] = *(const LAS bf16x8*)(lds + PG8_SB(b, h) + boff + n * 2048 + k * 1024); } while (0)
#define PG8_MMA(ai, bj, At, Bt) do { __builtin_amdgcn_s_setprio(1); _Pragma("unroll") for (int m = 0; m < 4; ++m) _Pragma("unroll") for (int n = 0; n < 2; ++n) _Pragma("unroll") for (int k = 0; k < 2; ++k) \
        acc[ai][bj][m][n] = __builtin_amdgcn_mfma_f32_16x16x32_bf16(Bt[n][k], At[m][k], acc[ai][bj][m][n], 0, 0, 0); __builtin_amdgcn_s_setprio(0); } while (0)
#define PG8_WAIT_V(n) asm volatile("s_waitcnt vmcnt(" #n ")" ::: "memory")
#define PG8_WAIT_L(n) asm volatile("s_waitcnt lgkmcnt(" #n ")" ::: "memory")
#define PG8_BAR __builtin_amdgcn_s_barrier()
#define PG8_SCHED __builtin_amdgcn_sched_barrier(0)
    Unit cur, nxt; int ui = 0;
    if (!S.next(0, cur)) return;
    f32x4 acc[2][2][4][2];
#pragma unroll
    for (int a = 0; a < 2; ++a)
#pragma unroll
        for (int b = 0; b < 2; ++b)
#pragma unroll
            for (int m = 0; m < 4; ++m)
#pragma unroll
                for (int n = 0; n < 2; ++n) acc[a][b][m][n] = (f32x4){0.f, 0.f, 0.f, 0.f};
    bf16x8 At[4][2], B0[2][2], B1[2][2];
    const char* cA = (const char*)g.A + (size_t)cur.pm * tsA; const char* cB = (const char*)g.Bt + (size_t)cur.pn * tsB;
    PG8_STAGE(PG8_SB(0, 0), cB, voffB); PG8_STAGE(PG8_SA(0, 0), cA, voffA); PG8_STAGE(PG8_SB(0, 1), cB + hsB, voffB); PG8_STAGE(PG8_SA(0, 1), cA + hsA, voffA);
    if (wr == 1) PG8_BAR;
    PG8_WAIT_V(4); PG8_BAR;
    PG8_STAGE(PG8_SB(1, 0), cB + kstep, voffB); PG8_STAGE(PG8_SA(1, 0), cA + kstep, voffA); PG8_STAGE(PG8_SB(1, 1), cB + hsB + kstep, voffB);
    PG8_WAIT_V(6); PG8_BAR;
    for (;;) {
        const bool has_next = S.next(ui + 1, nxt);
        const char* nA = has_next ? (const char*)g.A + (size_t)nxt.pm * tsA : cA; const char* nB = has_next ? (const char*)g.Bt + (size_t)nxt.pn * tsB : cB;
        for (int t = 0; t < nt; t += 2) {
            const bool last = (t == nt - 2);
            const char* a1 = cA + (size_t)(t + 1) * kstep;
            const char* a2 = last ? nA : cA + (size_t)(t + 2) * kstep; const char* b2 = last ? nB : cB + (size_t)(t + 2) * kstep;
            const char* a3 = a2 + kstep; const char* b3 = b2 + kstep;
            PG8_LDB(B0, 0, 0); PG8_SCHED; PG8_LDA(At, 0, 0); PG8_STAGE(PG8_SA(1, 1), a1 + hsA, voffA);
            PG8_WAIT_L(8); PG8_BAR; PG8_WAIT_L(0); PG8_MMA(0, 0, At, B0); PG8_BAR; PG8_SCHED;
            PG8_LDB(B1, 0, 1); PG8_STAGE(PG8_SB(0, 0), b2, voffB);
            PG8_BAR; PG8_WAIT_L(0); PG8_MMA(0, 1, At, B1); PG8_BAR;
            PG8_LDA(At, 0, 1); PG8_STAGE(PG8_SA(0, 0), a2, voffA);
            PG8_BAR; PG8_WAIT_L(0); PG8_MMA(1, 0, At, B0); PG8_BAR; PG8_SCHED;
            PG8_STAGE(PG8_SB(0, 1), b2 + hsB, voffB);
            PG8_WAIT_V(6); PG8_BAR; PG8_MMA(1, 1, At, B1); PG8_BAR;
            PG8_LDB(B0, 1, 0); PG8_SCHED; PG8_LDA(At, 1, 0); PG8_STAGE(PG8_SA(0, 1), a2 + hsA, voffA);
            PG8_WAIT_L(8); PG8_BAR; PG8_WAIT_L(0); PG8_MMA(0, 0, At, B0); PG8_BAR; PG8_SCHED;
            PG8_LDB(B1, 1, 1); PG8_STAGE(PG8_SB(1, 0), b3, voffB);
            PG8_BAR; PG8_WAIT_L(0); PG8_MMA(0, 1, At, B1); PG8_BAR;
            PG8_LDA(At, 1, 1); PG8_STAGE(PG8_SA(1, 0), a3, voffA);
            PG8_BAR; PG8_WAIT_L(0); PG8_MMA(1, 0, At, B0); PG8_BAR; PG8_SCHED;
            PG8_STAGE(PG8_SB(1, 1), b3 + hsB, voffB);
            PG8_WAIT_V(6); PG8_BAR; PG8_MMA(1, 1, At, B1); PG8_BAR;
        }
        E(acc, cur, wr, wc, fr, fq);
        if (!has_next) break;
#pragma unroll
        for (int a = 0; a < 2; ++a)
#pragma unroll
            for (int b = 0; b < 2; ++b)
#pragma unroll
                for (int m = 0; m < 4; ++m)
#pragma unroll
                    for (int n = 0; n < 2; ++n) acc[a][b][m][n] = (f32x4){0.f, 0.f, 0.f, 0.f};
        cur = nxt; cA = nA; cB = nB; ++ui;
    }
    PG8_WAIT_V(0);
    if (wr == 0) PG8_BAR;
    PG8_BAR;
#undef PG8_SA
#undef PG8_SB
#undef PG8_STAGE
#undef PG8_LDA
#undef PG8_LDB
#undef PG8_MMA
#undef PG8_WAIT_V
#undef PG8_WAIT_L
#undef PG8_BAR
#undef PG8_SCHED
}
template <class F> struct EpiB { static constexpr bool PERM = true; F f;
    __device__ __forceinline__ void operator()(const f32x4 (&acc)[2][2][4][2], const Unit& u, int wr, int wc, int fr, int fq) const {
#pragma unroll
        for (int ai = 0; ai < 2; ++ai)
#pragma unroll
            for (int m = 0; m < 4; ++m)
#pragma unroll
                for (int bj = 0; bj < 2; ++bj) {
                    const int row = u.pm * BM + ai * HALF + wr * 64 + m * 16 + fr, col = u.pn * BM + bj * HALF + wc * 32 + 8 * fq;
                    float v[8] = {acc[ai][bj][m][0][0], acc[ai][bj][m][0][1], acc[ai][bj][m][0][2], acc[ai][bj][m][0][3], acc[ai][bj][m][1][0], acc[ai][bj][m][1][1], acc[ai][bj][m][1][2], acc[ai][bj][m][1][3]};
                    f(row, col, v); }
    } };
template <class F> struct EpiF { static constexpr bool PERM = false; F f;
    __device__ __forceinline__ void operator()(const f32x4 (&acc)[2][2][4][2], const Unit& u, int wr, int wc, int fr, int fq) const {
#pragma unroll
        for (int ai = 0; ai < 2; ++ai)
#pragma unroll
            for (int m = 0; m < 4; ++m)
#pragma unroll
                for (int bj = 0; bj < 2; ++bj)
#pragma unroll
                    for (int n = 0; n < 2; ++n) {
                        const int row = u.pm * BM + ai * HALF + wr * 64 + m * 16 + fr, col = u.pn * BM + bj * HALF + wc * 32 + 16 * n + 4 * fq;
                        f(row, col, acc[ai][bj][m][n]); }
    } };
}

struct FStore { bf16_t* O; int ldc;
    __device__ __forceinline__ void operator()(int row, int col, float (&v)[8]) const { *(u32x4*)(O + (size_t)row * ldc + col) = pack8(v); } };
struct FSilu { bf16_t* O; int ldc;
    __device__ __forceinline__ void operator()(int row, int col, float (&v)[8]) const {
#pragma unroll
        for (int j = 0; j < 8; ++j) v[j] = silu(v[j]);
        *(u32x4*)(O + (size_t)row * ldc + col) = pack8(v); } };
struct FGate { const bf16_t* XR; const bf16_t* XR128; bf16_t* Y;
    __device__ __forceinline__ void operator()(int row, int col, float (&v)[8]) const {
        constexpr float NRM = 0.011048543456039806f;
        const int g = col >> 8, k20 = col & 255, b = row >> 13, k1 = row & (SEQ - 1);
        float f[8];
        if (k20 < 128) unpack8(*(const u32x4*)(XR + (size_t)row * 2048 + g * 128 + k20), f);
        else {
            const bf16_t* xm = XR + (size_t)(b * SEQ + ((SEQ - k1) & (SEQ - 1))) * 2048 + g * 128;
            float lo[8]; unpack8(*(const u32x4*)(xm + 248 - k20), lo);
#pragma unroll
            for (int j = 1; j < 8; ++j) f[j] = lo[8 - j];
            f[0] = (k20 == 128) ? bf2f(XR128[(size_t)row * 16 + g]) : bf2f(xm[256 - k20]);
        }
#pragma unroll
        for (int j = 0; j < 8; ++j) v[j] = silu(v[j]) * NRM * f[j];
        *(u32x4*)(Y + (size_t)row * LDY + col) = pack8(v); } };
struct FZ { bf16_t* Z; bf16_t* SG0;
    __device__ __forceinline__ void operator()(int row, int col, float (&v)[8]) const {
        if (col < ZW) { *(u32x4*)(Z + (size_t)row * ZW + col) = pack8(v); }
        else {
#pragma unroll
            for (int j = 0; j < 8; ++j) v[j] = silu(v[j]);
            *(u32x4*)(SG0 + (size_t)row * 2048 + (col - ZW)) = pack8(v); } } };
struct FQa { bf16_t* Qa;
    __device__ __forceinline__ void operator()(int row, int col, float (&v)[8]) const {
        const int d = col % 192;
        if (d >= 128 && row < NLAT) { const int s = row & (SEQ - 1); rope8(v, (d - 128) >> 1, 16, (float)(s >> 6), (float)(s & 63)); }
        *(u32x4*)(Qa + (size_t)row * 1536 + col) = pack8(v); } };
struct FKva { bf16_t* Ka; bf16_t* Va;
    __device__ __forceinline__ void operator()(int row, int col, float (&v)[8]) const {
        const int head = col >> 8, dd = col & 255, d = dd & 127; int b, pos;
        if (row < NLAT) { b = row >> 13; pos = CTX + (row & (SEQ - 1)); } else { const int cr = row - NLAT; b = cr >> 8; pos = cr & 255; }
        bf16_t* dst = (dd >= 128 ? Va : Ka) + ((size_t)((b * 8 + head) * LKV + pos) * 128 + d);
        *(u32x4*)dst = pack8(v); } };
struct FRes { const float* xin; const float* gate; float* out;
    __device__ __forceinline__ void operator()(int row, int col, const f32x4& a) const {
        const int b = row >> 13; const size_t idx = (size_t)row * DM + col;
        const f32x4 xv = *(const f32x4*)(xin + idx), gv = *(const f32x4*)(gate + b * 6144 + col);
        *(f32x4*)(out + idx) = xv * ALPHA + gv * a; } };
struct FDelta { const float* gate; bf16_t* D; int ldd;
    __device__ __forceinline__ void operator()(int row, int col, float (&v)[8]) const {
        const int b = row < NLAT ? (row >> 13) : 2; const f32x4 g0 = *(const f32x4*)(gate + b * 6144 + col), g1 = *(const f32x4*)(gate + b * 6144 + col + 4);
        v[0] *= g0[0]; v[1] *= g0[1]; v[2] *= g0[2]; v[3] *= g0[3]; v[4] *= g1[0]; v[5] *= g1[1]; v[6] *= g1[2]; v[7] *= g1[3];
        *(u32x4*)(D + (size_t)row * ldd + col) = pack8(v); } };
struct FXr { bf16_t* XR; bf16_t* XR128;
    __device__ __forceinline__ void operator()(int row, int col, float (&v)[8]) const {
        if (col < 65536) { const int k2 = col & 127, s = (col >> 7) & 15, bg = col >> 11, b = bg >> 4, g = bg & 15;
            *(u32x4*)(XR + (size_t)(b * SEQ + 16 * row + s) * 2048 + g * 128 + k2) = pack8(v); }
        else { const int c = col - 65536, bg = c >> 4, s0 = c & 15, b = bg >> 4, g = bg & 15;
#pragma unroll
            for (int j = 0; j < 8; ++j) XR128[(size_t)(b * SEQ + 16 * row + s0 + j) * 16 + g] = f2bf(v[j]); } } };

#define KSWZ(row, colB) ((row) * 256 + ((colB) ^ (((row) & 7) << 4)))
#define XSWZ(row, colB) ((row) * 128 + ((colB) ^ (((row) & 7) << 4)))
#define SBAR() __builtin_amdgcn_sched_barrier(0)
constexpr int A_SHM_V = 64 * 128 * 2, A_SHM_K = 64 * 128 * 2, A_SHM_X = 64 * 64 * 2;
__device__ __forceinline__ unsigned cvtpk_v(float lo, float hi) { unsigned r; asm volatile("v_cvt_pk_bf16_f32 %0, %1, %2" : "=v"(r) : "v"(lo), "v"(hi)); return r; }
__device__ __forceinline__ int crow(int r, int hi) { return (r & 3) + 8 * (r >> 2) + 4 * hi; }
__device__ __forceinline__ void partialSM(f32x16& p0, f32x16& p1, float& m_reg, float& mn, float& alpha, const float SCALE) {
    const float C = SCALE * 1.4426950408889634f; const float THRS = 8.f / SCALE;
    float pmax = p0[0];
#pragma unroll
    for (int r = 1; r < 16; ++r) pmax = fmaxf(pmax, p0[r]);
#pragma unroll
    for (int r = 0; r < 16; ++r) pmax = fmaxf(pmax, p1[r]);
    { auto rr = __builtin_amdgcn_permlane32_swap(__float_as_uint(pmax), __float_as_uint(pmax), false, false);
      pmax = fmaxf(__uint_as_float(rr[0]), __uint_as_float(rr[1])); }
    if (__builtin_expect(__all(pmax - m_reg <= THRS), 1)) { mn = m_reg; alpha = 1.f; }
    else { mn = fmaxf(m_reg, pmax); alpha = __builtin_amdgcn_exp2f((m_reg - mn) * C); m_reg = mn; }
    const float mnC = -mn * C;
#pragma unroll
    for (int r = 0; r < 16; ++r) p0[r] = fmaf(p0[r], C, mnC);
#pragma unroll
    for (int r = 0; r < 16; ++r) p1[r] = fmaf(p1[r], C, mnC);
#pragma unroll
    for (int r = 0; r < 16; ++r) p0[r] = __builtin_amdgcn_exp2f(p0[r]);
}
__device__ __forceinline__ void finishSM(f32x16& p0, f32x16& p1, float alpha, float& l_reg, bf16x8& pa0, bf16x8& pa1, bf16x8& pa2, bf16x8& pa3) {
#pragma unroll
    for (int r = 0; r < 16; ++r) p1[r] = __builtin_amdgcn_exp2f(p1[r]);
    float ps = 0;
#pragma unroll
    for (int r = 0; r < 16; ++r) ps += p0[r];
#pragma unroll
    for (int r = 0; r < 16; ++r) ps += p1[r];
    { auto rr = __builtin_amdgcn_permlane32_swap(__float_as_uint(ps), __float_as_uint(ps), false, false);
      ps = __uint_as_float(rr[0]) + __uint_as_float(rr[1]); }
    l_reg = l_reg * alpha + ps;
#define PK4(P, BASE, OUT) do { unsigned a0 = cvtpk_v(P[BASE + 0], P[BASE + 1]), a1 = cvtpk_v(P[BASE + 2], P[BASE + 3]);   \
    unsigned b0 = cvtpk_v(P[BASE + 4], P[BASE + 5]), b1 = cvtpk_v(P[BASE + 6], P[BASE + 7]);                              \
    auto r0 = __builtin_amdgcn_permlane32_swap(a0, b0, false, false); auto r1 = __builtin_amdgcn_permlane32_swap(a1, b1, false, false); \
    u32x4 w = {r0[0], r1[0], r0[1], r1[1]}; OUT = *reinterpret_cast<bf16x8*>(&w); } while (0)
    PK4(p0, 0, pa0); PK4(p0, 8, pa1); PK4(p1, 0, pa2); PK4(p1, 8, pa3);
#undef PK4
}
template <int XD>
__device__ __forceinline__ void qkt(f32x16& p0, f32x16& p1, const char* Ks, const char* Xs, const bf16x8* qr, const bf16x8* qx, int r32, int hi) {
    p0 = f32x16{}; p1 = f32x16{};
#pragma unroll
    for (int d0 = 0; d0 < 8; ++d0) { const int cb = (d0 * 16 + hi * 8) * 2;
        bf16x8 b0 = *reinterpret_cast<const bf16x8*>(Ks + KSWZ(r32, cb));
        bf16x8 b1 = *reinterpret_cast<const bf16x8*>(Ks + KSWZ(32 + r32, cb));
        p0 = __builtin_amdgcn_mfma_f32_32x32x16_bf16(b0, qr[d0], p0, 0, 0, 0);
        p1 = __builtin_amdgcn_mfma_f32_32x32x16_bf16(b1, qr[d0], p1, 0, 0, 0); }
    if constexpr (XD > 0) {
#pragma unroll
        for (int d0 = 0; d0 < XD / 16; ++d0) { const int cb = (d0 * 16 + hi * 8) * 2;
            bf16x8 b0 = *reinterpret_cast<const bf16x8*>(Xs + XSWZ(r32, cb));
            bf16x8 b1 = *reinterpret_cast<const bf16x8*>(Xs + XSWZ(32 + r32, cb));
            p0 = __builtin_amdgcn_mfma_f32_32x32x16_bf16(b0, qx[d0], p0, 0, 0, 0);
            p1 = __builtin_amdgcn_mfma_f32_32x32x16_bf16(b1, qx[d0], p1, 0, 0, 0); }
    }
}
__device__ __forceinline__ int v_st(int k, int c) { const int kk = (k & ~0xC) | ((k & 4) << 1) | ((k & 8) >> 1); return ((kk >> 3) * 4 + (c >> 5)) * 512 + ((kk & 7) * 32 + (c & 31)) * 2; }
__device__ __forceinline__ int v_rd_base(int lane) { return ((lane & 3) << 3) | (((lane >> 2) & 3) << 6) | (((lane >> 4) & 1) << 5) | (((lane >> 5) & 1) << 8); }
constexpr int v_rd_off(int d0, int ks, int half) { return d0 * 512 + ks * 4096 + half * 2048; }
template <int OFF> __device__ __forceinline__ s16x4 tr_read(int vb) {
    s16x4 r; asm volatile("ds_read_b64_tr_b16 %0, %1 offset:%2" : "=&v"(r) : "v"(vb), "i"(OFF) : "memory"); return r;
}
template <int D0> __device__ __forceinline__ void pv_one(f32x16& od, int vb, bf16x8 pa0, bf16x8 pa1, bf16x8 pa2, bf16x8 pa3) {
    const s16x4 l0 = tr_read<v_rd_off(D0, 0, 0)>(vb), h0 = tr_read<v_rd_off(D0, 0, 1)>(vb), l1 = tr_read<v_rd_off(D0, 1, 0)>(vb), h1 = tr_read<v_rd_off(D0, 1, 1)>(vb);
    const s16x4 l2 = tr_read<v_rd_off(D0, 2, 0)>(vb), h2 = tr_read<v_rd_off(D0, 2, 1)>(vb), l3 = tr_read<v_rd_off(D0, 3, 0)>(vb), h3 = tr_read<v_rd_off(D0, 3, 1)>(vb);
    asm volatile("s_waitcnt lgkmcnt(0)" ::: "memory"); SBAR();
#define PK(L, H) (bf16x8){L[0], L[1], L[2], L[3], H[0], H[1], H[2], H[3]}
    od = __builtin_amdgcn_mfma_f32_32x32x16_bf16(pa0, PK(l0, h0), od, 0, 0, 0);
    od = __builtin_amdgcn_mfma_f32_32x32x16_bf16(pa1, PK(l1, h1), od, 0, 0, 0);
    od = __builtin_amdgcn_mfma_f32_32x32x16_bf16(pa2, PK(l2, h2), od, 0, 0, 0);
    od = __builtin_amdgcn_mfma_f32_32x32x16_bf16(pa3, PK(l3, h3), od, 0, 0, 0);
#undef PK
}
__device__ __forceinline__ void pv_d0(f32x16* o, int vb, bf16x8 pa0, bf16x8 pa1, bf16x8 pa2, bf16x8 pa3) {
    pv_one<0>(o[0], vb, pa0, pa1, pa2, pa3); pv_one<1>(o[1], vb, pa0, pa1, pa2, pa3); pv_one<2>(o[2], vb, pa0, pa1, pa2, pa3); pv_one<3>(o[3], vb, pa0, pa1, pa2, pa3);
}
template <int XD, int SDEPTH, int LDQ>
__device__ __forceinline__ void attn_body(const bf16_t* __restrict__ Qb, const bf16_t* __restrict__ Kh, const bf16_t* __restrict__ Vh, const bf16_t* __restrict__ Kx,
                                          bf16_t* __restrict__ Yb, int seq, char* lds, const float SCALE, const bool dry) {
    const int tid = tid_l(), wid = tid >> 6, lane = tid & 63, r32 = lane & 31, hi = lane >> 5;
    char* V_lds = lds; char* K_lds = lds + 2 * A_SHM_V; char* X_lds = lds + 2 * A_SHM_V + 2 * A_SHM_K;
    float* wsf = (float*)(lds + 2 * A_SHM_V + 2 * A_SHM_K + 2 * A_SHM_X) + wid * 64; float* li_l = wsf; float* al_l = wsf + 32;
    float m_reg = -1e30f, l_reg = 0; f32x16 o[4] = {}; bf16x8 qr[8]; bf16x8 qx[XD > 0 ? XD / 16 : 1];
    const bf16_t* Qw = Qb + (long)(wid * 32 + r32) * LDQ + hi * 8;
#pragma unroll
    for (int d0 = 0; d0 < 8; ++d0) qr[d0] = *reinterpret_cast<const bf16x8*>(Qw + d0 * 16);
    if constexpr (XD > 0) {
#pragma unroll
        for (int d0 = 0; d0 < XD / 16; ++d0) qx[d0] = *reinterpret_cast<const bf16x8*>(Qw + 128 + d0 * 16);
    }
    const int sr = tid >> 4, sc = (tid & 15) * 8, vst0 = v_st(sr, sc), vst1 = v_st(32 + sr, sc);
    const int xr = tid >> 3, xc = (tid & 7) * 8;
    const int vb0 = (int)(uintptr_t)V_lds + v_rd_base(lane);
    struct { bf16x8 vs0, vs1, ks0, ks1, xs; } sr_[SDEPTH];
#define SLOAD(i, k0) do { sr_[i].vs0 = *(const bf16x8*)(&Vh[(long)((k0) + sr) * 128 + sc]); sr_[i].vs1 = *(const bf16x8*)(&Vh[(long)((k0) + 32 + sr) * 128 + sc]); \
    sr_[i].ks0 = *(const bf16x8*)(&Kh[(long)((k0) + sr) * 128 + sc]); sr_[i].ks1 = *(const bf16x8*)(&Kh[(long)((k0) + 32 + sr) * 128 + sc]); \
    if constexpr (XD > 0) sr_[i].xs = *(const bf16x8*)(&Kx[(long)((k0) + xr) * 64 + xc]); } while (0)
#define SWRITE(b, i) do { *(bf16x8*)(V_lds + (b) * A_SHM_V + vst0) = sr_[i].vs0;          \
    *(bf16x8*)(V_lds + (b) * A_SHM_V + vst1) = sr_[i].vs1; int kc = sc * 2;               \
    *(bf16x8*)(K_lds + (b) * A_SHM_K + KSWZ(sr, kc)) = sr_[i].ks0;                       \
    *(bf16x8*)(K_lds + (b) * A_SHM_K + KSWZ(32 + sr, kc)) = sr_[i].ks1;                  \
    if constexpr (XD > 0) *(bf16x8*)(X_lds + (b) * A_SHM_X + XSWZ(xr, xc * 2)) = sr_[i].xs; } while (0)
#define SWAIT() do { if constexpr (SDEPTH == 2) { if constexpr (XD > 0) asm volatile("s_waitcnt vmcnt(5)" ::: "memory"); else asm volatile("s_waitcnt vmcnt(4)" ::: "memory"); } \
    else asm volatile("s_waitcnt vmcnt(0)" ::: "memory"); } while (0)
#define RESC(a) do { if (__any((a) < 1.f)) { if (hi == 0) al_l[r32] = (a); asm volatile("s_waitcnt lgkmcnt(0)" ::: "memory"); \
    _Pragma("unroll") for (int d = 0; d < 4; ++d) _Pragma("unroll") for (int r = 0; r < 16; ++r) o[d][r] *= al_l[crow(r, hi)]; } } while (0)
    f32x16 pA0, pA1, pB0, pB1; float mnA, mnB, alA, alB; bf16x8 pa0, pa1, pa2, pa3; const int NT = seq / 64;
    constexpr int SE = 0, SO = SDEPTH - 1;
    SLOAD(SE, 0); asm volatile("s_waitcnt vmcnt(0)" ::: "memory"); SWRITE(0, SE); __syncthreads();
    qkt<XD>(pA0, pA1, K_lds, X_lds, qr, qx, r32, hi); partialSM(pA0, pA1, m_reg, mnA, alA, SCALE);
    SLOAD(SO, 64); if constexpr (SDEPTH == 2) { if (2 < NT) SLOAD(SE, 2 * 64); }
    SWAIT(); SWRITE(1, SO); __syncthreads();
    for (int j = 1; j + 1 < NT; j += 2) {
        SBAR(); qkt<XD>(pB0, pB1, K_lds + A_SHM_K, X_lds + A_SHM_X, qr, qx, r32, hi);
        finishSM(pA0, pA1, alA, l_reg, pa0, pa1, pa2, pa3); SBAR();
        SLOAD(SO, (j + SDEPTH) * 64); SBAR();
        pv_d0(o, vb0, pa0, pa1, pa2, pa3); partialSM(pB0, pB1, m_reg, mnB, alB, SCALE);
        __syncthreads(); SWAIT(); SWRITE(0, SE);
        RESC(alB); __syncthreads();
        SBAR(); qkt<XD>(pA0, pA1, K_lds, X_lds, qr, qx, r32, hi);
        finishSM(pB0, pB1, alB, l_reg, pa0, pa1, pa2, pa3); SBAR();
        if (SDEPTH == 1 || j + 3 < NT) SLOAD(SE, (j + 1 + SDEPTH) * 64); SBAR();
        pv_d0(o, vb0 + A_SHM_V, pa0, pa1, pa2, pa3); partialSM(pA0, pA1, m_reg, mnA, alA, SCALE);
        __syncthreads(); SWAIT(); SWRITE(1, SO);
        RESC(alA); __syncthreads();
    }
    SBAR(); qkt<XD>(pB0, pB1, K_lds + A_SHM_K, X_lds + A_SHM_X, qr, qx, r32, hi);
    finishSM(pA0, pA1, alA, l_reg, pa0, pa1, pa2, pa3); SBAR();
    pv_d0(o, vb0, pa0, pa1, pa2, pa3); partialSM(pB0, pB1, m_reg, mnB, alB, SCALE);
    __syncthreads(); RESC(alB);
    finishSM(pB0, pB1, alB, l_reg, pa0, pa1, pa2, pa3); SBAR();
    pv_d0(o, vb0 + A_SHM_V, pa0, pa1, pa2, pa3);
    if (hi == 0) li_l[r32] = l_reg; asm volatile("s_waitcnt lgkmcnt(0)" ::: "memory");
    float rli[16];
#pragma unroll
    for (int r = 0; r < 16; ++r) rli[r] = __builtin_amdgcn_rcpf(li_l[crow(r, hi)]);
    bf16_t* Yw = Yb + (long)(wid * 32) * 2048;
    if (!dry)
#pragma unroll
    for (int r = 0; r < 16; ++r) { const int orow = crow(r, hi);
#pragma unroll
        for (int d0 = 0; d0 < 4; ++d0) { bf16_t* yp = Yw + (long)orow * 2048 + d0 * 32 + r32; *yp = f2bf(o[d0][r] * rli[r] * bf2f(*yp)); } }
    __syncthreads();
#undef SLOAD
#undef SWRITE
#undef SWAIT
#undef RESC
}

__device__ __forceinline__ void tconv_tile(const float* src, int ld, int k0, int sc0, bf16_t* dst, int ldd, int n0, float* tile) {
    const int tid = tid_l();
#pragma unroll
    for (int i = 0; i < 2; ++i) { const int r = (tid >> 4) + 32 * i, c = (tid & 15) * 4;
        f32x4 v = {0.f, 0.f, 0.f, 0.f}; if (sc0 >= 0) v = *(const f32x4*)(src + (size_t)(k0 + r) * ld + sc0 + c);
        tile[r * 65 + c] = v[0]; tile[r * 65 + c + 1] = v[1]; tile[r * 65 + c + 2] = v[2]; tile[r * 65 + c + 3] = v[3]; }
    __syncthreads();
    { const int n = tid >> 3, k8 = (tid & 7) * 8; float v[8];
#pragma unroll
      for (int j = 0; j < 8; ++j) v[j] = tile[(k8 + j) * 65 + n];
      *(u32x4*)(dst + (size_t)(n0 + n) * ldd + k0 + k8) = pack8(v); }
    __syncthreads();
}
__device__ __forceinline__ int wi_src(int n0) {
    if (n0 < 1280) return n0;
    if (n0 < 2304) return 1344 + (n0 - 1280);
    if (n0 < 2560) return 2368 + (n0 - 2304);
    if (n0 < 2816) return 2624 + (n0 - 2560);
    if (n0 < 2880) return 1280 + (n0 - 2816);
    if (n0 < 3072) return -1;
    return 2880 + (n0 - 3072);
}

__device__ __forceinline__ void phase_prep(const Params& p, float* ldsf) {
    const int tid = tid_l(), G = gridDim.x, bid = blockIdx.x, lane = tid & 63, wid = tid >> 6;
    unsigned char* ws = p.ws;
    if (bid == 0) { unsigned* bw = (unsigned*)(ws + OFF_BAR); for (int i = tid; i < 3456; i += 512) bw[i] = 0u; }
    float* sv = ldsf; float* red = ldsf + 3 * 2048;
    for (int i = tid; i < 3 * 2048; i += 512) { const int vec = i >> 11, k = i & 2047; const float v = vec < 2 ? p.c[vec * 2048 + k] : p.c_ctx[k]; sv[i] = silu(v); }
    __syncthreads();
    float* mod = (float*)(ws + OFF_MOD);
    for (int unit = bid; unit < 384; unit += G) {
        const int layer = unit / 192, col0 = (unit % 192) * 32, kc = tid >> 3, c4 = (tid & 7) * 4;
        const float* W = p.ada_w + (size_t)layer * 2048 * 6144 + col0 + c4;
        f32x4 a0 = {0, 0, 0, 0}, a1 = a0, a2 = a0;
#pragma unroll 4
        for (int i = 0; i < 32; ++i) { const int k = kc + 64 * i; const f32x4 w = *(const f32x4*)(W + (size_t)k * 6144);
            a0 += w * sv[k]; a1 += w * sv[2048 + k]; a2 += w * sv[4096 + k]; }
#pragma unroll
        for (int j = 0; j < 4; ++j) {
            a0[j] += xor_swz<8>(a0[j]); a1[j] += xor_swz<8>(a1[j]); a2[j] += xor_swz<8>(a2[j]);
            a0[j] += xor_swz<16>(a0[j]); a1[j] += xor_swz<16>(a1[j]); a2[j] += xor_swz<16>(a2[j]);
            { auto r0 = __builtin_amdgcn_permlane32_swap(__float_as_uint(a0[j]), __float_as_uint(a0[j]), false, false); a0[j] = __uint_as_float(r0[0]) + __uint_as_float(r0[1]);
              auto r1 = __builtin_amdgcn_permlane32_swap(__float_as_uint(a1[j]), __float_as_uint(a1[j]), false, false); a1[j] = __uint_as_float(r1[0]) + __uint_as_float(r1[1]);
              auto r2 = __builtin_amdgcn_permlane32_swap(__float_as_uint(a2[j]), __float_as_uint(a2[j]), false, false); a2[j] = __uint_as_float(r2[0]) + __uint_as_float(r2[1]); } }
        if (lane < 8) {
#pragma unroll
            for (int j = 0; j < 4; ++j) { red[(wid * 3 + 0) * 32 + c4 + j] = a0[j]; red[(wid * 3 + 1) * 32 + c4 + j] = a1[j]; red[(wid * 3 + 2) * 32 + c4 + j] = a2[j]; } }
        __syncthreads();
        if (tid < 96) { const int vec = tid >> 5, cc = tid & 31; float s = 0;
#pragma unroll
            for (int w = 0; w < 8; ++w) s += red[(w * 3 + vec) * 32 + cc];
            mod[(layer * 3 + vec) * 6144 + col0 + cc] = s + p.ada_b[layer * 6144 + col0 + cc]; }
        __syncthreads();
    }
    __syncthreads();
    float* tile = ldsf;
    for (int T = bid; T < 8224; T += G) {
        int t = T;
        if (t < 2560) { const int kt = t & 31, nt = t >> 5; tconv_tile(p.w_in_attn, 4928, kt * 64, wi_src(nt * 64), (bf16_t*)(ws + OFF_WI), 2048, nt * 64, tile); continue; }
        t -= 2560;
        if (t < 288) { const int kt = t % 12, nt = t / 12; tconv_tile(p.wq_b, 1536, kt * 64, nt * 64, (bf16_t*)(ws + OFF_WQ), 768, nt * 64, tile); continue; }
        t -= 288;
        if (t < 256) { const int kt = t & 7, nt = t >> 3; tconv_tile(p.wkv_b, 2048, kt * 64, nt * 64, (bf16_t*)(ws + OFF_WKV), 512, nt * 64, tile); continue; }
        t -= 256;
        if (t < 1024) { const int kt = t & 31, nt = t >> 5; tconv_tile(p.w_out_attn, 2048, kt * 64, nt * 64, (bf16_t*)(ws + OFF_WO), 2048, nt * 64, tile); continue; }
        t -= 1024;
        if (t < 2048) { const int kt = t & 31, nt = t >> 5; tconv_tile(p.w_in_f, 8192, kt * 64, 4096 + nt * 64, (bf16_t*)(ws + OFF_WFG), 2048, nt * 64, tile); continue; }
        t -= 2048;
        { const int kt = t & 63, nt = t >> 6; tconv_tile(p.w_out_f, 2048, kt * 64, nt * 64, (bf16_t*)(ws + OFF_WOF), LDY, nt * 64, tile); }
    }
    { bf16_t* Wub = (bf16_t*)(ws + OFF_WUB);
      for (int i = bid * 512 + tid; i < 2048 * 512; i += G * 512) { const int k = i >> 9, c8 = (i & 511) * 8;
          const f32x4 a = *(const f32x4*)(p.w_in_f + (size_t)k * 8192 + c8), b = *(const f32x4*)(p.w_in_f + (size_t)k * 8192 + c8 + 4);
          float v[8] = {a[0], a[1], a[2], a[3], b[0], b[1], b[2], b[3]}; *(u32x4*)(Wub + (size_t)k * 4096 + c8) = pack8(v); } }
    { bf16_t* Tt = (bf16_t*)(ws + OFF_TT);
      for (int i = bid * 512 + tid; i < 65536; i += G * 512) { const int j = i >> 8, n2 = i & 255; const int jj = j <= 128 ? j : j - 128;
          const float rev = (float)((jj * n2) & 255) * (1.f / 256.f); const float v = (j <= 128 ? cos_rev(rev) : sin_rev(rev)) * 0.0625f; Tt[i] = f2bf(v); } }
    { bf16_t* Tr = (bf16_t*)(ws + OFF_TRIG);
      for (int i = bid * 512 + tid; i < 512 * 1024; i += G * 512) { const int m = i >> 10, n = i & 1023, np = n & 511;
          const float rev = (float)((m * np) & 511) * (1.f / 512.f); Tr[i] = f2bf(n < 512 ? cos_rev(rev) : sin_rev(rev)); } }
}

__device__ __forceinline__ void row_stats(const f32x4 (&v)[8], float& mean, float& rstd) {
    float s = 0;
#pragma unroll
    for (int i = 0; i < 8; ++i) s += v[i][0] + v[i][1] + v[i][2] + v[i][3];
    mean = wave_sum(s) * (1.f / 2048.f);
    float q = 0;
#pragma unroll
    for (int i = 0; i < 8; ++i) { const f32x4 d = v[i] - mean; q += d[0] * d[0] + d[1] * d[1] + d[2] * d[2] + d[3] * d[3]; }
    rstd = rsqrtf(wave_sum(q) * (1.f / 2048.f) + 1e-6f);
}
__device__ __forceinline__ void mod_store(const f32x4 (&v)[8], float mean, float rstd, const float* shift, const float* scale, bf16_t* hr, int lane) {
#pragma unroll
    for (int i = 0; i < 8; ++i) { const int c = i * 256 + lane * 4; const f32x4 sc = *(const f32x4*)(scale + c), sh = *(const f32x4*)(shift + c);
        const f32x4 y = (v[i] - mean) * rstd * (sc + 1.f) + sh; u32x2 w; w.x = cvtpk(y[0], y[1]); w.y = cvtpk(y[2], y[3]); *(u32x2*)(hr + c) = w; }
}

__device__ __forceinline__ void phase_ln0(const Params& p) {
    const int tid = tid_l(), lane = tid & 63, wid = tid >> 6, G = gridDim.x;
    const float* mod = (const float*)(p.ws + OFF_MOD); bf16_t* H = (bf16_t*)(p.ws + OFF_H);
    for (int r = blockIdx.x * 8 + wid; r < NTOK; r += G * 8) {
        const float* xr; int vec;
        if (r < NLAT) { xr = p.x + (size_t)r * DM; vec = r >> 13; } else { xr = p.ctx + (size_t)(r - NLAT) * DM; vec = 2; }
        f32x4 v[8];
#pragma unroll
        for (int i = 0; i < 8; ++i) v[i] = *(const f32x4*)(xr + i * 256 + lane * 4);
        float mean, rstd; row_stats(v, mean, rstd);
        mod_store(v, mean, rstd, mod + vec * 6144, mod + vec * 6144 + 2048, H + (size_t)r * DM, lane);
    }
}
__device__ __forceinline__ void phase_fold(const Params& p, LAS unsigned char* lds, int first_wg) {
    for (int w = (int)blockIdx.x - first_wg; w >= 0 && w < 128; w += (int)gridDim.x - first_wg) {
        const int g = w >> 3;
        pg8::Gemm gm{(const bf16_t*)(p.ws + OFF_TT), (const bf16_t*)(p.ws + OFF_WUB) + g * 256, 256, 2048, 256, 256, 4096};
        pg8::OneUnit S{0, w & 7};
        pg8::EpiB<FStore> E{FStore{(bf16_t*)(p.ws + OFF_WFU) + (size_t)g * 256 * 2048, 2048}};
        pg8::gemm_phase(lds, gm, S, E);
    }
}

__device__ __forceinline__ void phase_postz(const Params& p) {
    const int tid = tid_l(), lane = tid & 63, wid = tid >> 6, G = gridDim.x;
    unsigned char* ws = p.ws;
    const bf16_t* Z = (const bf16_t*)(ws + OFF_Z);
    bf16_t* CQN = (bf16_t*)(ws + OFF_CQN); bf16_t* CKVN = (bf16_t*)(ws + OFF_CKVN); bf16_t* QB = (bf16_t*)(ws + OFF_QB);
    bf16_t* KB = (bf16_t*)(ws + OFF_KB); bf16_t* VB = (bf16_t*)(ws + OFF_VB); bf16_t* KPE = (bf16_t*)(ws + OFF_KPE);
    for (int r = ((int)blockIdx.x - 40) * 8 + wid; r < NTOK; r += (G - 40) * 8) {
        const bf16_t* zr = Z + (size_t)r * ZW; const bool lat = r < NLAT; int b, pos, s;
        if (lat) { b = r >> 13; s = r & (SEQ - 1); pos = CTX + s; } else { const int cr = r - NLAT; b = cr >> 8; pos = cr & 255; s = 0; }
        const float prow = (float)(s >> 6), pcol = (float)(s & 63);
        float v[8];
        {
            float v2[8]; unpack8(*(const u32x4*)(zr + lane * 8), v); float ss = 0;
#pragma unroll
            for (int j = 0; j < 8; ++j) ss += v[j] * v[j];
            if (lane < 32) { unpack8(*(const u32x4*)(zr + 512 + lane * 8), v2);
#pragma unroll
                for (int j = 0; j < 8; ++j) ss += v2[j] * v2[j]; }
            const float rstd = rsqrtf(wave_sum(ss) * (1.f / 768.f) + 1e-6f);
#pragma unroll
            for (int j = 0; j < 8; ++j) v[j] = v[j] * rstd * p.q_lora_g[lane * 8 + j];
            *(u32x4*)(CQN + (size_t)r * 768 + lane * 8) = pack8(v);
            if (lane < 32) {
#pragma unroll
                for (int j = 0; j < 8; ++j) v2[j] = v2[j] * rstd * p.q_lora_g[512 + lane * 8 + j];
                *(u32x4*)(CQN + (size_t)r * 768 + 512 + lane * 8) = pack8(v2); }
        }
        {
            unpack8(*(const u32x4*)(zr + 768 + lane * 8), v); float ss = 0;
#pragma unroll
            for (int j = 0; j < 8; ++j) ss += v[j] * v[j];
            const float rstd = rsqrtf(wave_sum(ss) * (1.f / 512.f) + 1e-6f);
#pragma unroll
            for (int j = 0; j < 8; ++j) v[j] = v[j] * rstd * p.kv_lora_g[lane * 8 + j];
            *(u32x4*)(CKVN + (size_t)r * 512 + lane * 8) = pack8(v);
        }
        const int d = (lane & 15) * 8;
        {
#pragma unroll
            for (int ps = 0; ps < 2; ++ps) {
                unpack8(*(const u32x4*)(zr + 1280 + ps * 512 + lane * 8), v); float ss = 0;
#pragma unroll
                for (int j = 0; j < 8; ++j) ss += v[j] * v[j];
                const float rstd = rsqrtf(sum16(ss) * (1.f / 128.f) + 1e-6f);
#pragma unroll
                for (int j = 0; j < 8; ++j) v[j] = v[j] * rstd * p.qn_g[d + j];
                if (lat) rope8(v, d >> 1, 32, prow, pcol);
                *(u32x4*)(QB + (size_t)r * 1024 + ps * 512 + lane * 8) = pack8(v);
            }
        }
        {
            unpack8(*(const u32x4*)(zr + 2304 + lane * 8), v); float ss = 0;
#pragma unroll
            for (int j = 0; j < 8; ++j) ss += v[j] * v[j];
            const float rstd = rsqrtf(sum16(ss) * (1.f / 128.f) + 1e-6f);
            const int head = (lane >> 4) & 1; const bool isV = lane >= 32;
            if (!isV) {
#pragma unroll
                for (int j = 0; j < 8; ++j) v[j] = v[j] * rstd * p.kn_g[d + j];
                if (lat) rope8(v, d >> 1, 32, prow, pcol);
            }
            bf16_t* dst = (isV ? VB : KB) + ((size_t)((b * 2 + head) * LKV + pos) * 128 + d);
            *(u32x4*)dst = pack8(v);
        }
        if (lane < 8) {
            unpack8(*(const u32x4*)(zr + 2816 + lane * 8), v);
            if (lat) rope8(v, lane * 4, 16, prow, pcol);
            *(u32x4*)(KPE + (size_t)(b * LKV + pos) * 64 + lane * 8) = pack8(v);
        }
    }
}

__device__ __forceinline__ void phase_ln1(const Params& p) {
    const int tid = tid_l(), lane = tid & 63, wid = tid >> 6, G = gridDim.x;
    const float* mod1 = (const float*)(p.ws + OFF_MOD) + 3 * 6144; bf16_t* H1 = (bf16_t*)(p.ws + OFF_H1); const bf16_t* D0 = (const bf16_t*)p.out + 2048;
    for (int r = ((int)blockIdx.x - 16) * 8 + wid; r < NLAT; r += (G - 16) * 8) {
        const int vec = r >> 13; const float* xin = p.x + (size_t)r * DM; const bf16_t* dr = D0 + (size_t)r * 4096;
        f32x4 v[8];
#pragma unroll
        for (int i = 0; i < 8; ++i) { const int c = i * 256 + lane * 4; const f32x4 xv = *(const f32x4*)(xin + c); const u32x2 dw = *(const u32x2*)(dr + c);
            v[i] = xv * ALPHA + (f32x4){bflo(dw.x), bfhi(dw.x), bflo(dw.y), bfhi(dw.y)}; }
        float mean, rstd; row_stats(v, mean, rstd);
#pragma unroll
        for (int i = 0; i < 8; ++i) { const int c = i * 256 + lane * 4; const f32x4 g = *(const f32x4*)(p.ln_g + c), bb = *(const f32x4*)(p.ln_b + c);
            v[i] = (v[i] - mean) * rstd * g + bb; }
        row_stats(v, mean, rstd);
        mod_store(v, mean, rstd, mod1 + vec * 6144, mod1 + vec * 6144 + 2048, H1 + (size_t)r * DM, lane);
    }
}
__device__ __forceinline__ void phase_xc(const Params& p) {
    const int tid = tid_l(), lane = tid & 63, wid = tid >> 6, G = gridDim.x;
    const bf16_t* DC = (const bf16_t*)(p.ws + OFF_DC); float* XC = (float*)(p.ws + OFF_XC);
    for (int r = blockIdx.x * 8 + wid; r < NB * CTX; r += G * 8) {
        const float* xin = p.ctx + (size_t)r * DM; const bf16_t* dr = DC + (size_t)r * DM;
        f32x4 v[8];
#pragma unroll
        for (int i = 0; i < 8; ++i) { const int c = i * 256 + lane * 4; const f32x4 xv = *(const f32x4*)(xin + c); const u32x2 dw = *(const u32x2*)(dr + c);
            v[i] = xv * ALPHA + (f32x4){bflo(dw.x), bfhi(dw.x), bflo(dw.y), bfhi(dw.y)}; }
        float mean, rstd; row_stats(v, mean, rstd);
#pragma unroll
        for (int i = 0; i < 8; ++i) { const int c = i * 256 + lane * 4; const f32x4 g = *(const f32x4*)(p.ln_g + c), bb = *(const f32x4*)(p.ln_b + c);
            *(f32x4*)(XC + (size_t)r * DM + c) = (v[i] - mean) * rstd * g + bb; }
    }
}
__device__ __forceinline__ void phase_ln2(const Params& p) {
    const int tid = tid_l(), lane = tid & 63, wid = tid >> 6, G = gridDim.x;
    for (int r = blockIdx.x * 8 + wid; r < NLAT; r += G * 8) {
        float* xr = p.out + (size_t)r * DM; const float* xin = p.x + (size_t)r * DM;
        const bf16_t* d0r = (const bf16_t*)p.out + (size_t)r * 4096 + 2048; const bf16_t* d2r = (const bf16_t*)(p.ws + OFF_D2) + (size_t)r * DM;
        f32x4 v[8]; u32x2 d2w[8];
#pragma unroll
        for (int i = 0; i < 8; ++i) { const int c = i * 256 + lane * 4; const f32x4 xv = *(const f32x4*)(xin + c); const u32x2 dw = *(const u32x2*)(d0r + c); d2w[i] = *(const u32x2*)(d2r + c);
            v[i] = xv * ALPHA + (f32x4){bflo(dw.x), bfhi(dw.x), bflo(dw.y), bfhi(dw.y)}; }
        float mean, rstd; row_stats(v, mean, rstd);
#pragma unroll
        for (int i = 0; i < 8; ++i) { const int c = i * 256 + lane * 4; const f32x4 g = *(const f32x4*)(p.ln_g + c), bb = *(const f32x4*)(p.ln_b + c);
            const f32x4 x1 = (v[i] - mean) * rstd * g + bb;
            v[i] = x1 * ALPHA + (f32x4){bflo(d2w[i].x), bfhi(d2w[i].x), bflo(d2w[i].y), bfhi(d2w[i].y)}; }
        row_stats(v, mean, rstd);
#pragma unroll
        for (int i = 0; i < 8; ++i) { const int c = i * 256 + lane * 4; const f32x4 g = *(const f32x4*)(p.ln_g + DM + c), bb = *(const f32x4*)(p.ln_b + DM + c);
            *(f32x4*)(xr + c) = (v[i] - mean) * rstd * g + bb; }
    }
}

__device__ __forceinline__ void dft4(const float (&xr)[4][2], const float (&xi)[4][2], float (&tr)[4][2], float (&ti)[4][2]) {
#pragma unroll
    for (int e = 0; e < 2; ++e) {
        const float ar = xr[0][e] + xr[2][e], ai = xi[0][e] + xi[2][e], br = xr[0][e] - xr[2][e], bi = xi[0][e] - xi[2][e];
        const float cr = xr[1][e] + xr[3][e], ci = xi[1][e] + xi[3][e], dr = xr[1][e] - xr[3][e], di = xi[1][e] - xi[3][e];
        tr[0][e] = ar + cr; ti[0][e] = ai + ci;
        tr[2][e] = ar - cr; ti[2][e] = ai - ci;
        tr[1][e] = br + di; ti[1][e] = bi - dr;
        tr[3][e] = br - di; ti[3][e] = bi + dr;
    }
}
__device__ __forceinline__ void phase_radix16(const Params& p) {
    const int tid = tid_l(), G = gridDim.x, half = tid >> 8, np = (tid & 255) * 2;
    const bf16_t* PT = (const bf16_t*)(p.ws + OFF_PT); bf16_t* ZS = (bf16_t*)(p.ws + OFF_ZS);
    unsigned pw[16], qw[16];
    auto issue = [&](int u) {
        int bg, k2; if (u < 2048) { bg = u >> 6; k2 = (u & 63) * 2 + half; } else { bg = (u - 2048) * 2 + half; k2 = 128; }
        const int b = bg >> 4, g = bg & 15;
        const bf16_t* Pp = PT + (size_t)(g * 256 + k2) * NLAT + b * SEQ + np;
        const bool hasQ = (k2 >= 1 && k2 <= 127);
        const bf16_t* Qp = PT + (size_t)(g * 256 + 128 + k2) * NLAT + b * SEQ + np;
#pragma unroll
        for (int q = 0; q < 16; ++q) { pw[q] = *(const unsigned*)(Pp + 512 * q); qw[q] = hasQ ? *(const unsigned*)(Qp + 512 * q) : 0u; }
    };
    if ((int)blockIdx.x < 2064) issue(blockIdx.x);
    for (int u = blockIdx.x; u < 2064; u += G) {
        int bg, k2; if (u < 2048) { bg = u >> 6; k2 = (u & 63) * 2 + half; } else { bg = (u - 2048) * 2 + half; k2 = 128; }
        float zr[16][2], zi[16][2];
#pragma unroll
        for (int q = 0; q < 16; ++q) { zr[q][0] = bflo(pw[q]); zr[q][1] = bfhi(pw[q]); zi[q][0] = -bflo(qw[q]); zi[q][1] = -bfhi(qw[q]); }
        if (u + G < 2064) issue(u + G);
        float ur[4][4][2], ui[4][4][2];
#pragma unroll
        for (int q0 = 0; q0 < 4; ++q0) {
            float xr[4][2], xi[4][2], tr[4][2], ti[4][2];
#pragma unroll
            for (int q1 = 0; q1 < 4; ++q1) { xr[q1][0] = zr[4 * q1 + q0][0]; xr[q1][1] = zr[4 * q1 + q0][1]; xi[q1][0] = zi[4 * q1 + q0][0]; xi[q1][1] = zi[4 * q1 + q0][1]; }
            dft4(xr, xi, tr, ti);
#pragma unroll
            for (int s0 = 0; s0 < 4; ++s0) {
                constexpr float C16[10] = {1.f, 0.92387953251128674f, 0.70710678118654752f, 0.38268343236508977f, 0.f, -0.38268343236508977f, -0.70710678118654752f, -0.92387953251128674f, -1.f, -0.92387953251128674f};
                constexpr float S16[10] = {0.f, 0.38268343236508977f, 0.70710678118654752f, 0.92387953251128674f, 1.f, 0.92387953251128674f, 0.70710678118654752f, 0.38268343236508977f, 0.f, -0.38268343236508977f};
                const float ck = C16[s0 * q0], sk = S16[s0 * q0];
#pragma unroll
                for (int e = 0; e < 2; ++e) { ur[q0][s0][e] = tr[s0][e] * ck + ti[s0][e] * sk; ui[q0][s0][e] = ti[s0][e] * ck - tr[s0][e] * sk; }
            }
        }
#pragma unroll
        for (int s0 = 0; s0 < 4; ++s0) {
            float xr[4][2], xi[4][2], yr[4][2], yi[4][2];
#pragma unroll
            for (int q0 = 0; q0 < 4; ++q0) { xr[q0][0] = ur[q0][s0][0]; xr[q0][1] = ur[q0][s0][1]; xi[q0][0] = ui[q0][s0][0]; xi[q0][1] = ui[q0][s0][1]; }
            dft4(xr, xi, yr, yi);
#pragma unroll
            for (int s1 = 0; s1 < 4; ++s1) {
                const int sq = s0 + 4 * s1; float a[2], bq[2];
#pragma unroll
                for (int e = 0; e < 2; ++e) { const float rev = (float)(sq * (np + e)) * (1.f / 8192.f); const float cs = cos_rev(rev), sn = sin_rev(rev);
                    a[e] = yr[s1][e] * cs + yi[s1][e] * sn; bq[e] = yi[s1][e] * cs - yr[s1][e] * sn; }
                const size_t rho = (u < 2048) ? (size_t)((bg * 16 + sq) * 128 + k2) : (size_t)(65536 + bg * 16 + sq);
                *(unsigned*)(ZS + rho * 1024 + np) = cvtpk(a[0], a[1]);
                *(unsigned*)(ZS + rho * 1024 + 512 + np) = cvtpk(bq[0], bq[1]);
            }
        }
    }
}

__device__ __forceinline__ void phase_combine(const Params& p) {
    const int tid = tid_l(), lane = tid & 63, wid = tid >> 6, G = gridDim.x;
    const bf16_t* XR = (const bf16_t*)(p.ws + OFF_XR); const bf16_t* XR128 = (const bf16_t*)(p.ws + OFF_XR128); bf16_t* SG = (bf16_t*)(p.ws + OFF_SG);
    constexpr float NRM = 0.011048543456039806f;
    for (int r = blockIdx.x * 8 + wid; r < NLAT; r += G * 8) {
        const int b = r >> 13, k1 = r & (SEQ - 1), rm = b * SEQ + ((SEQ - k1) & (SEQ - 1));
        const bf16_t* x0 = XR + (size_t)r * 2048; const bf16_t* xm = XR + (size_t)rm * 2048; bf16_t* sg = SG + (size_t)r * 4096;
#pragma unroll
        for (int it = 0; it < 8; ++it) {
            const int c0 = (it * 64 + lane) * 8, g = c0 >> 8, k20 = c0 & 255;
            float f[8], gt[8]; unpack8(*(const u32x4*)(sg + c0), gt);
            if (k20 < 128) unpack8(*(const u32x4*)(x0 + g * 128 + k20), f);
            else {
#pragma unroll
                for (int j = 0; j < 8; ++j) { const int k2 = k20 + j; f[j] = (k2 == 128) ? bf2f(XR128[(size_t)r * 16 + g]) : bf2f(xm[g * 128 + 256 - k2]); } }
#pragma unroll
            for (int j = 0; j < 8; ++j) f[j] = f[j] * NRM * gt[j];
            *(u32x4*)(sg + c0) = pack8(f);
        }
    }
}

#define XB_TMO      128
#define XB_XCNT(j)  (256  + 64 * (j))
#define XB_XSUB(j)  (1280 + 64 * (j))
#define XB_XGEN(j)  (2304 + 64 * (j))
#define XB_TOP      3328
#define XB_TOPGEN   3392
#define XCD_BAR_WORDS 3456
#define XB_SPIN_CAP (1u << 20)
__device__ __forceinline__ unsigned xb_ld(unsigned* p)              { return __hip_atomic_load(p, __ATOMIC_RELAXED, __HIP_MEMORY_SCOPE_AGENT); }
__device__ __forceinline__ unsigned xb_add(unsigned* p, unsigned v) { return __hip_atomic_fetch_add(p, v, __ATOMIC_RELAXED, __HIP_MEMORY_SCOPE_AGENT); }
__device__ __forceinline__ unsigned xb_xcc_id() { return (unsigned)__builtin_amdgcn_s_getreg((3 << 11) | 20) & 0xFu; }
#define XB_SPIN(cond, bar) do { unsigned _sp = 0; while (cond) { __builtin_amdgcn_s_sleep(1); \
    if ((++_sp & 255u) == 0u) { if (xb_ld(&(bar)[XB_TMO])) break; if (_sp > XB_SPIN_CAP) { atomicAdd(&(bar)[XB_TMO], 1u); break; } } } } while (0)
struct XcdBarrier { unsigned* bar; unsigned x; volatile LAS unsigned* st; };
__device__ __forceinline__ XcdBarrier xcd_barrier_post(unsigned* bar, volatile LAS unsigned* st) {
    XcdBarrier b; b.bar = bar; b.x = xb_xcc_id(); b.st = st;
    if (threadIdx.x == 0) (void)xb_add(&bar[XB_XCNT(b.x)], 1u);
    return b;
}
__device__ __forceinline__ void xcd_barrier_complete(unsigned* bar, unsigned x, unsigned& nloc, unsigned& nx) {
    const unsigned G = gridDim.x * gridDim.y * gridDim.z;
    unsigned sum, cnt, mine, sp = 0u;
    for (;;) {
        sum = 0u; cnt = 0u; mine = 0u;
#pragma unroll
        for (unsigned j = 0; j < 16; ++j) { const unsigned c = xb_ld(&bar[XB_XCNT(j)]); sum += c; cnt += (c > 0u) ? 1u : 0u; mine = (j == x) ? c : mine; }
        if (sum == G) break;
        __builtin_amdgcn_s_sleep(1);
        if ((++sp & 255u) == 0u) { if (xb_ld(&bar[XB_TMO])) break; if (sp > XB_SPIN_CAP) { atomicAdd(&bar[XB_TMO], 1u); break; } }
    }
    nloc = mine > 0u ? mine : 1u; nx = cnt > 0u ? cnt : 1u;
}
__device__ __forceinline__ void xcd_barrier(const XcdBarrier& b) {
    asm volatile("s_waitcnt vmcnt(0)" ::: "memory");
    __syncthreads();
    if (threadIdx.x == 0) {
        unsigned* bar = b.bar;
        __builtin_amdgcn_s_waitcnt(0);
        unsigned nloc = b.st[0], nx = b.st[1];
        if (nloc == 0u) { xcd_barrier_complete(bar, b.x, nloc, nx); b.st[0] = nloc; b.st[1] = nx; }
        const unsigned old = xb_add(&bar[XB_XSUB(b.x)], 1u);
        const unsigned gen = old / nloc;
        if (old + 1u == (gen + 1u) * nloc) {
            __builtin_amdgcn_fence(__ATOMIC_RELEASE, "agent");
            asm volatile("s_waitcnt vmcnt(0)" ::: "memory");
            const unsigned og = xb_add(&bar[XB_TOP], 1u);
            const unsigned tg = og / nx;
            if (og + 1u == (tg + 1u) * nx) xb_add(&bar[XB_TOPGEN], 1u);
            else XB_SPIN(xb_ld(&bar[XB_TOPGEN]) == tg, bar);
            __builtin_amdgcn_fence(__ATOMIC_ACQUIRE, "agent");
            xb_add(&bar[XB_XGEN(b.x)], 1u);
            asm volatile("s_waitcnt vmcnt(0)" ::: "memory");
        } else {
            XB_SPIN(xb_ld(&bar[XB_XGEN(b.x)]) == gen, bar);
            __builtin_amdgcn_fence(__ATOMIC_ACQUIRE, "agent");
            asm volatile("s_waitcnt vmcnt(0)" ::: "memory");
        }
    }
    __syncthreads();
}

__global__ __launch_bounds__(512) void mega(Params p) {
    extern __shared__ __attribute__((aligned(16))) unsigned char shm[];
    cg::grid_group grid = cg::this_grid();
    LAS unsigned char* lds = (LAS unsigned char*)shm;
    unsigned char* ws = p.ws;
    const int G = gridDim.x, bid = blockIdx.x;
    const float* mod = (const float*)(ws + OFF_MOD);
    volatile LAS unsigned* bst = (volatile LAS unsigned*)(lds + LDS_STAGE);
    if (threadIdx.x < 2) bst[threadIdx.x] = 0u;
    __syncthreads();
    XcdBarrier xb; xb.bar = (unsigned*)(ws + OFF_BAR); xb.x = 0; xb.st = bst;
    for (int ph = p.ph_lo; ph < p.ph_hi; ++ph) {
      const int reps = (ph == REP_PH) ? 2 : 1;
      for (int rep = 0; rep < reps; ++rep) {
        const bool dry = rep + 1 < reps; (void)dry;
        if (rep) grid.sync();
        if (((STAGGER_MASK >> ph) & 1) && ((bid >> 3) & 1)) {
            const unsigned long long t0 = __builtin_amdgcn_s_memrealtime(); while (__builtin_amdgcn_s_memrealtime() - t0 < STAGGER_TICKS) __builtin_amdgcn_s_sleep(8); }
        if (PH_ON(0) && ph == 0) phase_prep(p, (float*)shm);
        else if (PH_ON(1) && ph == 1) phase_ln0(p);
        else if (PH_ON(3) && ph == 3 && bid >= 40) phase_postz(p);
        else if (PH_ON(2) && (ph == 2 || ph == 3)) {
            {
                pg8::Gemm gm{(const bf16_t*)(ws + OFF_H), (const bf16_t*)(ws + OFF_WI), NTOK, NWI, 2048, 2048, 2048};
                pg8::MixOrder S; S.so.init(64 * 256, NWI, G, bid); S.one = (ph == 3); S.remap = true; S.pm = 61 + (bid >> 3); S.pn = 12 + (bid & 7);
                pg8::EpiB<FZ> E{FZ{(bf16_t*)(ws + OFF_Z), (bf16_t*)(ws + OFF_SG0)}};
                pg8::gemm_phase(lds, gm, S, E);
            }
        }
        else if (PH_ON(4) && ph == 4) {
            { pg8::Gemm gm{(const bf16_t*)(ws + OFF_CQN), (const bf16_t*)(ws + OFF_WQ), NTOK, 1536, 768, 768, 768};
              pg8::StaticOrder S; S.init(gm.M, gm.N, G, bid);
              pg8::EpiB<FQa> E{FQa{(bf16_t*)(ws + OFF_QA)}};
              pg8::gemm_phase(lds, gm, S, E); }
            { pg8::Gemm gm{(const bf16_t*)(ws + OFF_CKVN), (const bf16_t*)(ws + OFF_WKV), NTOK, 2048, 512, 512, 512};
              pg8::StaticOrder S; S.init(gm.M, gm.N, G, (bid + G - 140) % G);
              pg8::EpiB<FKva> E{FKva{(bf16_t*)(ws + OFF_KA), (bf16_t*)(ws + OFF_VA)}};
              pg8::gemm_phase(lds, gm, S, E); }
            phase_fold(p, lds, 156);
        }
        else if (PH_ON(5) && ph == 5) {
            bf16_t* Y = (bf16_t*)(ws + OFF_SG0);
            for (int u = bid; u < 256; u += G) {
                const int qblk = u >> 3;
                const int nA = (u < 16) ? 3 : 2, nB = (u >= 16 && u < 32) ? 3 : 2;
                for (int it = 0; it < nA; ++it) {
                    const int b = it < 2 ? it : ((u >> 3) & 1), head = u & 7, seq = it < 2 ? LKV : CTX;
                    const size_t t0 = it < 2 ? (size_t)b * SEQ + qblk * 256 : (size_t)NLAT + b * CTX;
                    attn_body<64, 1, 1536>((const bf16_t*)(ws + OFF_QA) + t0 * 1536 + head * 192,
                                           (const bf16_t*)(ws + OFF_KA) + (size_t)(b * 8 + head) * LKV * 128, (const bf16_t*)(ws + OFF_VA) + (size_t)(b * 8 + head) * LKV * 128,
                                           (const bf16_t*)(ws + OFF_KPE) + (size_t)b * LKV * 64, Y + t0 * 2048 + head * 128, seq, (char*)shm, 0.07216878364870322f, dry);
                }
                for (int it = 0; it < nB; ++it) {
                    const int b = it < 2 ? it : ((u >> 3) & 1), head = u & 7, kvh = head >> 2, seq = it < 2 ? LKV : CTX;
                    const size_t t0 = it < 2 ? (size_t)b * SEQ + qblk * 256 : (size_t)NLAT + b * CTX;
                    attn_body<0, 2, 1024>((const bf16_t*)(ws + OFF_QB) + t0 * 1024 + head * 128,
                                          (const bf16_t*)(ws + OFF_KB) + (size_t)(b * 2 + kvh) * LKV * 128, (const bf16_t*)(ws + OFF_VB) + (size_t)(b * 2 + kvh) * LKV * 128,
                                          nullptr, Y + t0 * 2048 + 1024 + head * 128, seq, (char*)shm, 0.08838834764831845f, dry);
                }
            }
        }
        else if (PH_ON(6) && (ph == 6 || ph == 7)) {
            if (ph == 6 || bid < 16) {
                pg8::Gemm gm{(const bf16_t*)(ws + OFF_SG0), (const bf16_t*)(ws + OFF_WO), NLAT, 2048, 2048, 2048, 2048};
                pg8::MixOrder S; S.so.init(gm.M, gm.N, G, bid); S.one = (ph == 7); S.remap = false; S.pm = 64 + (bid >> 3); S.pn = bid & 7;
                pg8::EpiB<FDelta> E{FDelta{mod + 4096, ph == 6 ? (bf16_t*)p.out + 2048 : (bf16_t*)(ws + OFF_DC) - (size_t)NLAT * DM, ph == 6 ? 4096 : 2048}};
                pg8::gemm_phase(lds, gm, S, E);
            } else phase_ln1(p);
        }
        else if (PH_ON(8) && ph == 8) {
            phase_xc(p);
            { pg8::Gemm gm{(const bf16_t*)(ws + OFF_WFU), (const bf16_t*)(ws + OFF_H1), 4096, NLAT, 2048, 2048, 2048};
              pg8::StaticOrder S; S.init(gm.M, gm.N, G, bid);
              pg8::EpiB<FStore> E{FStore{(bf16_t*)(ws + OFF_PT), NLAT}};
              pg8::gemm_phase(lds, gm, S, E); }
        }
        else if (PH_ON(9) && ph == 9) phase_radix16(p);
        else if (PH_ON(10) && ph == 10) {
            pg8::Gemm gm{(const bf16_t*)(ws + OFF_TRIG), (const bf16_t*)(ws + OFF_ZS), 512, NZS, 1024, 1024, 1024};
            pg8::StaticOrder S; S.init(gm.M, gm.N, G, bid);
            pg8::EpiB<FXr> E{FXr{(bf16_t*)(ws + OFF_XR), (bf16_t*)(ws + OFF_XR128)}};
            pg8::gemm_phase(lds, gm, S, E);
        }
        else if (PH_ON(11) && ph == 11) {
            pg8::Gemm gm{(const bf16_t*)(ws + OFF_H1), (const bf16_t*)(ws + OFF_WFG), NLAT, 4096, 2048, 2048, 2048};
            pg8::StaticOrder S; S.init(gm.M, gm.N, G, bid);
            pg8::EpiB<FGate> E{FGate{(const bf16_t*)(ws + OFF_XR), (const bf16_t*)(ws + OFF_XR128), (bf16_t*)(ws + OFF_SG)}};
            pg8::gemm_phase(lds, gm, S, E);
        }
        else if (PH_ON(12) && ph == 12) {
            pg8::Gemm gm{(const bf16_t*)(ws + OFF_SG), (const bf16_t*)(ws + OFF_WOF), NLAT, 2048, 4096, LDY, LDY};
            pg8::StaticOrder S; S.init(gm.M, gm.N, G, bid);
            pg8::EpiB<FDelta> E{FDelta{mod + 3 * 6144 + 4096, (bf16_t*)(ws + OFF_D2), 2048}};
            pg8::gemm_phase(lds, gm, S, E);
        }
        else if (PH_ON(13) && ph == 13) phase_ln2(p);
      }
        if (ph + 1 < p.ph_hi) {
            if (ph == 0) { grid.sync(); xb = xcd_barrier_post((unsigned*)(ws + OFF_BAR), bst); }
            else xcd_barrier(xb); }
    }
}

extern "C" void kernel_launch(void* const* d_in, const int* in_sizes, int n_in, void* d_out, int out_size, void* d_ws, size_t ws_size, hipStream_t stream) {
    static int grid = 0;
    if (grid == 0) {
        if (n_in != 18 || in_sizes[0] != NLAT * DM || out_size != NLAT * DM || ws_size < WS_NEED) {
            fprintf(stderr, "kernel_launch: shape/workspace mismatch (n_in %d, in0 %d, out %d, ws %zu, need %zu)\n", n_in, n_in > 0 ? in_sizes[0] : -1, out_size, ws_size, (size_t)WS_NEED); grid = -1; return; }
        int dev = 0, cus = 0, per_cu = 0;
        (void)hipGetDevice(&dev); (void)hipDeviceGetAttribute(&cus, hipDeviceAttributeMultiprocessorCount, dev);
        if (hipFuncSetAttribute((const void*)mega, hipFuncAttributeMaxDynamicSharedMemorySize, LDS_BYTES) != hipSuccess) { fprintf(stderr, "kernel_launch: hipFuncSetAttribute failed\n"); grid = -1; return; }
        if (hipOccupancyMaxActiveBlocksPerMultiprocessor(&per_cu, (const void*)mega, 512, LDS_BYTES) != hipSuccess || per_cu < 1) { fprintf(stderr, "kernel_launch: occupancy query says %d\n", per_cu); per_cu = 1; }
        (void)hipGetLastError();
        grid = cus * 1;
        if (grid > 256) grid = 256;
    }
    if (grid < 0) return;
    Params p{};
    p.x = (const float*)d_in[0]; p.c = (const float*)d_in[1]; p.ctx = (const float*)d_in[2]; p.c_ctx = (const float*)d_in[3]; p.ada_w = (const float*)d_in[4]; p.ada_b = (const float*)d_in[5];
    p.ln_g = (const float*)d_in[6]; p.ln_b = (const float*)d_in[7]; p.w_in_attn = (const float*)d_in[8]; p.wq_b = (const float*)d_in[9]; p.q_lora_g = (const float*)d_in[10];
    p.kv_lora_g = (const float*)d_in[11]; p.wkv_b = (const float*)d_in[12]; p.qn_g = (const float*)d_in[13]; p.kn_g = (const float*)d_in[14]; p.w_out_attn = (const float*)d_in[15];
    p.w_in_f = (const float*)d_in[16]; p.w_out_f = (const float*)d_in[17]; p.out = (float*)d_out; p.ws = (unsigned char*)d_ws;
#if MK_MULTI
    for (int ph = 0; ph < NPH; ++ph) { p.ph_lo = ph; p.ph_hi = ph + 1; hipLaunchKernelGGL(mega, dim3(grid), dim3(512), LDS_BYTES, stream, p); }
#else
    p.ph_lo = 0; p.ph_hi = NPH;
    void* args[] = {&p};
    hipError_t e = hipLaunchCooperativeKernel((const void*)mega, dim3(grid), dim3(512), args, LDS_BYTES, stream);
    if (e != hipSuccess) fprintf(stderr, "kernel_launch: cooperative launch failed: %s (grid %d)\n", hipGetErrorString(e), grid);
#endif
}
```
